# Optimizing an MI355X kernel written in HIP

```python
import jax, jax.numpy as jnp
from jax import lax
import numpy as np

D_MODEL = 1024
BATCH = 2
SEQ = 16384
DEPTH = 1
DEC_BATCH = 32
DEC_SEQ = 32
PAST_LEN = 4096

CHUNK = 64
BAND_CHUNKS = 8
ATT_BAND = BAND_CHUNKS * CHUNK
A_HEADS = 8
A_DH = 64
A_WIDTH = A_HEADS * A_DH
M_HEADS = 4
M_DH = 128
M_WIDTH = M_HEADS * M_DH
D_MIX = A_WIDTH + M_WIDTH
REL_CLIP = 128
N_REL = 2 * REL_CLIP + 1
CONV_W = 4
D_FF = 2816
EPS = 1e-6
NEG = -1e30

OFF_AK = A_WIDTH
OFF_AV = 2 * A_WIDTH
OFF_MQK = 3 * A_WIDTH
OFF_MV = OFF_MQK + 2 * M_WIDTH
OFF_MO = OFF_MV + M_WIDTH
OFF_MG = OFF_MO + M_WIDTH
D_IN = OFF_MG + 2 * M_HEADS

kernel_name = 'hybrid_chunkband_attn_mlstm_stream_step'


def rmsnorm(x, g):
    xf = x.astype(jnp.float32)
    y = xf * lax.rsqrt(jnp.mean(xf * xf, axis=-1, keepdims=True) + EPS)
    return (y * g.astype(jnp.float32)).astype(x.dtype)


def head_rmsnorm(x, g, n_heads):
    B, L, W = x.shape
    y = rmsnorm(x.reshape(B, L, n_heads, W // n_heads), g.reshape(n_heads, W // n_heads))
    return y.reshape(B, L, W)


def ffn_half(x, g, w1, w3, w2):
    h = rmsnorm(x, g)
    return x + 0.5 * ((jax.nn.silu(h @ w1) * (h @ w3)) @ w2)


def causal_conv(u, buf, w, b):
    L = u.shape[1]
    full = jnp.concatenate([buf.astype(u.dtype), u], axis=1)
    y = b
    for j in range(CONV_W):
        y = y + full[:, j:j + L] * w[j]
    return y, full[:, full.shape[1] - (CONV_W - 1):]


def mixer_inputs(h, w_in, conv_w, conv_b, gate_bias, conv_buf):
    f32 = jnp.float32
    B, L = h.shape[:2]
    z = h @ w_in
    aq = z[..., :OFF_AK].reshape(B, L, A_HEADS, A_DH)
    ak = z[..., OFF_AK:OFF_AV].reshape(B, L, A_HEADS, A_DH)
    av = z[..., OFF_AV:OFF_MQK].reshape(B, L, A_HEADS, A_DH)
    qk, new_buf = causal_conv(z[..., OFF_MQK:OFF_MV], conv_buf, conv_w, conv_b)
    qk = jax.nn.silu(qk)
    to_heads = lambda t: t.reshape(B, L, M_HEADS, M_DH).transpose(0, 2, 1, 3).astype(f32)
    mq = to_heads(qk[..., :M_WIDTH])
    mk = to_heads(qk[..., M_WIDTH:]) * (M_DH ** -0.5)
    mv = to_heads(z[..., OFF_MV:OFF_MO])
    og = jax.nn.sigmoid(z[..., OFF_MO:OFF_MG])
    g = z[..., OFF_MG:D_IN].astype(f32) + gate_bias.astype(f32)
    ig = g[..., :M_HEADS].transpose(0, 2, 1)
    lf = jax.nn.log_sigmoid(g[..., M_HEADS:]).transpose(0, 2, 1)
    return (aq, ak, av), (mq, mk, mv, ig, lf), og, new_buf


def band_attention(q, k, v, qpos, kpos, kvalid, rel_bias):
    s = jnp.einsum('bqhd,bkhd->bhqk', q, k).astype(jnp.float32) * (A_DH ** -0.5)
    idx = jnp.clip(qpos[:, None] - kpos[None, :], -REL_CLIP, REL_CLIP) + REL_CLIP
    s = s + rel_bias[:, idx].astype(jnp.float32)[None]
    s = jnp.where(kvalid[None, None, None, :], s, NEG)
    p = jax.nn.softmax(s, axis=-1).astype(v.dtype)
    return jnp.einsum('bhqk,bkhd->bqhd', p, v)


def attn_prompt(q, k, v, rel_bias):
    B, S = q.shape[:2]
    nc = S // CHUNK
    pad = ((0, 0), (ATT_BAND, 0), (0, 0), (0, 0))
    kp = jnp.pad(k, pad)
    vp = jnp.pad(v, pad)
    qc = jnp.moveaxis(q.reshape(B, nc, CHUNK, A_HEADS, A_DH), 1, 0)
    band = ATT_BAND + CHUNK

    def one_chunk(args):
        c, qb = args
        start = c * CHUNK
        kb = lax.dynamic_slice_in_dim(kp, start, band, axis=1)
        vb = lax.dynamic_slice_in_dim(vp, start, band, axis=1)
        qpos = start + jnp.arange(CHUNK)
        kpos = start - ATT_BAND + jnp.arange(band)
        return band_attention(qb, kb, vb, qpos, kpos, kpos >= 0, rel_bias)

    out = lax.map(one_chunk, (jnp.arange(nc), qc))
    return jnp.moveaxis(out, 0, 1).reshape(B, S, A_WIDTH)


def attn_sample(q, k, v, ck, cv, rel_bias):
    Lc, T = ck.shape[1], q.shape[1]
    kk = jnp.concatenate([ck.astype(k.dtype), k], axis=1)
    vv = jnp.concatenate([cv.astype(v.dtype), v], axis=1)
    qpos = PAST_LEN + jnp.arange(T)
    kpos = PAST_LEN - Lc + jnp.arange(Lc + T)
    out = band_attention(q, kk, vv, qpos, kpos, jnp.ones((Lc + T,), bool), rel_bias)
    return out.reshape(q.shape[0], T, A_WIDTH)


def mlstm_chunk(carry, inp):
    C, n, m = carry
    q, k, v, ig, lf = inp
    L = q.shape[2]
    b = jnp.cumsum(lf, axis=-1)
    causal = jnp.tril(jnp.ones((L, L), bool))
    D = jnp.where(causal, b[..., :, None] - b[..., None, :] + ig[..., None, :], -jnp.inf)
    inter = b + m[..., None]
    mt = jnp.maximum(inter, jnp.max(D, axis=-1))
    Dw = jnp.exp(D - mt[..., None])
    iw = jnp.exp(inter - mt)
    s = jnp.einsum('bhtd,bhsd->bhts', q, k) * Dw
    num = iw[..., None] * jnp.einsum('bhtd,bhde->bhte', q, C) + jnp.einsum('bhts,bhse->bhte', s, v)
    den = iw * jnp.einsum('bhtd,bhd->bht', q, n) + jnp.sum(s, axis=-1)
    h = num / jnp.maximum(jnp.abs(den), jnp.exp(-mt))[..., None]
    bL = b[..., -1]
    m_new = mt[..., -1]
    wk = jnp.exp(bL[..., None] - b + ig - m_new[..., None])
    decay = jnp.exp(bL + m - m_new)
    C_new = decay[..., None, None] * C + jnp.einsum('bhs,bhsd,bhse->bhde', wk, k, v)
    n_new = decay[..., None] * n + jnp.einsum('bhs,bhsd->bhd', wk, k)
    return (C_new, n_new, m_new), h


def mlstm_prompt(mq, mk, mv, ig, lf):
    B, H, S, _ = mq.shape
    nc = S // CHUNK
    to_chunks = lambda t: jnp.moveaxis(t.reshape((B, H, nc, CHUNK) + t.shape[3:]), 2, 0)
    f32 = jnp.float32
    init = (jnp.zeros((B, H, M_DH, M_DH), f32), jnp.zeros((B, H, M_DH), f32), jnp.zeros((B, H), f32))
    carry, hs = lax.scan(mlstm_chunk, init, (to_chunks(mq), to_chunks(mk), to_chunks(mv), to_chunks(ig), to_chunks(lf)))
    h = jnp.moveaxis(hs, 0, 2).reshape(B, H, S, M_DH)
    return h, carry


def mixer_output(a_out, m_h, og, norm_m, w_out):
    B, L = a_out.shape[:2]
    m_h = m_h.transpose(0, 2, 1, 3).reshape(B, L, M_WIDTH).astype(a_out.dtype) * og
    m_h = head_rmsnorm(m_h, norm_m, M_HEADS)
    return jnp.concatenate([a_out, m_h], axis=-1) @ w_out


def setup_inputs(seed: int = 0) -> dict:
    key = jax.random.key(seed)
    ks = iter(jax.random.split(key, 40))
    f32 = jnp.float32

    def nrm(shape, scale):
        return jax.random.normal(next(ks), shape, f32) * scale

    def gain(shape):
        return 1.0 + nrm(shape, 0.02)

    att_cache = min(ATT_BAND, PAST_LEN)
    x_prompt = nrm((BATCH, SEQ, D_MODEL), 1.0)
    x_sample = nrm((DEC_BATCH, DEC_SEQ, D_MODEL), 1.0)
    cache_attn_k = nrm((DEPTH, DEC_BATCH, att_cache, A_HEADS, A_DH), 1.0)
    cache_attn_v = nrm((DEPTH, DEC_BATCH, att_cache, A_HEADS, A_DH), 1.0)
    state_mlstm_C = nrm((DEPTH, DEC_BATCH, M_HEADS, M_DH, M_DH), 0.3)
    state_mlstm_n = nrm((DEPTH, DEC_BATCH, M_HEADS, M_DH), 1.0)
    state_mlstm_m = nrm((DEPTH, DEC_BATCH, M_HEADS), 0.5)
    state_mlstm_conv = nrm((DEPTH, DEC_BATCH, CONV_W - 1, 2 * M_WIDTH), 1.0)
    fbias = jnp.linspace(3.0, 6.0, M_HEADS).astype(f32)
    gate_bias = jnp.concatenate([nrm((DEPTH, M_HEADS), 0.1), fbias + nrm((DEPTH, M_HEADS), 0.1)], axis=-1)
    return {
        'x_prompt': x_prompt,
        'x_sample': x_sample,
        'cache_attn_k': cache_attn_k,
        'cache_attn_v': cache_attn_v,
        'state_mlstm_C': state_mlstm_C,
        'state_mlstm_n': state_mlstm_n,
        'state_mlstm_m': state_mlstm_m,
        'state_mlstm_conv': state_mlstm_conv,
        'norm_ffn1': gain((DEPTH, D_MODEL)),
        'w1_ffn1': nrm((DEPTH, D_MODEL, D_FF), D_MODEL ** -0.5),
        'w3_ffn1': nrm((DEPTH, D_MODEL, D_FF), D_MODEL ** -0.5),
        'w2_ffn1': nrm((DEPTH, D_FF, D_MODEL), D_FF ** -0.5),
        'norm_mix': gain((DEPTH, D_MODEL)),
        'w_in': nrm((DEPTH, D_MODEL, D_IN), D_MODEL ** -0.5),
        'conv_w': nrm((DEPTH, CONV_W, 2 * M_WIDTH), CONV_W ** -0.5),
        'conv_b': nrm((DEPTH, 2 * M_WIDTH), 0.02),
        'gate_bias': gate_bias,
        'rel_bias': nrm((DEPTH, A_HEADS, N_REL), 0.2),
        'norm_mlstm_out': gain((DEPTH, M_WIDTH)),
        'w_out': nrm((DEPTH, D_MIX, D_MODEL), D_MIX ** -0.5),
        'norm_ffn2': gain((DEPTH, D_MODEL)),
        'w1_ffn2': nrm((DEPTH, D_MODEL, D_FF), D_MODEL ** -0.5),
        'w3_ffn2': nrm((DEPTH, D_MODEL, D_FF), D_MODEL ** -0.5),
        'w2_ffn2': nrm((DEPTH, D_FF, D_MODEL), D_FF ** -0.5),
        'norm_final': gain((D_MODEL,)),
    }


def reference(x_prompt, x_sample, cache_attn_k, cache_attn_v, state_mlstm_C, state_mlstm_n,
              state_mlstm_m, state_mlstm_conv, norm_ffn1, w1_ffn1, w3_ffn1, w2_ffn1,
              norm_mix, w_in, conv_w, conv_b, gate_bias, rel_bias, norm_mlstm_out, w_out,
              norm_ffn2, w1_ffn2, w3_ffn2, w2_ffn2, norm_final):
    f32 = jnp.float32
    B, S = x_prompt.shape[:2]
    keep = min(ATT_BAND, S)
    xp, xs = x_prompt, x_sample
    kp_l, vp_l, Cp_l, np_l, mp_l, cp_l = [], [], [], [], [], []
    ks_l, vs_l, Cs_l, ns_l, ms_l, cs_l = [], [], [], [], [], []
    for l in range(DEPTH):
        xp = ffn_half(xp, norm_ffn1[l], w1_ffn1[l], w3_ffn1[l], w2_ffn1[l])
        xs = ffn_half(xs, norm_ffn1[l], w1_ffn1[l], w3_ffn1[l], w2_ffn1[l])

        zero_buf = jnp.zeros((B, CONV_W - 1, 2 * M_WIDTH), xp.dtype)
        (aq, ak, av), mins, og, buf = mixer_inputs(rmsnorm(xp, norm_mix[l]), w_in[l], conv_w[l],
                                                   conv_b[l], gate_bias[l], zero_buf)
        a_out = attn_prompt(aq, ak, av, rel_bias[l])
        m_h, (C, n, m) = mlstm_prompt(*mins)
        xp = xp + mixer_output(a_out, m_h, og, norm_mlstm_out[l], w_out[l])
        kp_l.append(ak[:, S - keep:])
        vp_l.append(av[:, S - keep:])
        Cp_l.append(C)
        np_l.append(n)
        mp_l.append(m)
        cp_l.append(buf)

        (aq, ak, av), mins, og, buf = mixer_inputs(rmsnorm(xs, norm_mix[l]), w_in[l], conv_w[l],
                                                   conv_b[l], gate_bias[l], state_mlstm_conv[l])
        a_out = attn_sample(aq, ak, av, cache_attn_k[l], cache_attn_v[l], rel_bias[l])
        carry0 = (state_mlstm_C[l].astype(f32), state_mlstm_n[l].astype(f32), state_mlstm_m[l].astype(f32))
        (C, n, m), m_h = mlstm_chunk(carry0, mins)
        xs = xs + mixer_output(a_out, m_h, og, norm_mlstm_out[l], w_out[l])
        ks_l.append(ak)
        vs_l.append(av)
        Cs_l.append(C)
        ns_l.append(n)
        ms_l.append(m)
        cs_l.append(buf)

        xp = ffn_half(xp, norm_ffn2[l], w1_ffn2[l], w3_ffn2[l], w2_ffn2[l])
        xs = ffn_half(xs, norm_ffn2[l], w1_ffn2[l], w3_ffn2[l], w2_ffn2[l])

    y_prompt = rmsnorm(xp, norm_final)
    y_sample = rmsnorm(xs, norm_final)
    return (y_prompt, y_sample,
            jnp.stack(kp_l), jnp.stack(vp_l), jnp.stack(Cp_l), jnp.stack(np_l), jnp.stack(mp_l), jnp.stack(cp_l),
            jnp.stack(ks_l), jnp.stack(vs_l), jnp.stack(Cs_l), jnp.stack(ns_l), jnp.stack(ms_l), jnp.stack(cs_l))
```

```cpp
#include <hip/hip_runtime.h>
#include <hip/hip_cooperative_groups.h>
#include <cstdio>
#include <cstdint>
namespace cg = cooperative_groups;
namespace pg8 {
#define PG8_LAS __attribute__((address_space(3)))
typedef unsigned short bf16_t;
typedef short bf16x8 __attribute__((ext_vector_type(8)));
typedef float f32x4 __attribute__((ext_vector_type(4)));
typedef unsigned u32x4 __attribute__((ext_vector_type(4)));
typedef unsigned u32x2 __attribute__((ext_vector_type(2)));
constexpr int BM = 256, BK = 64, HALF = 128, HTB = HALF * BK * 2  , STAGE_BYTES = 8 * HTB, NXCD = 8, WGM = 8;

__host__ __device__ __forceinline__ int lds_byte(int r, int c) { const int st = (r >> 4) * 2 + (c >> 5), rr = r & 15, cc = c & 31, ob = rr * 64 + cc * 2; return st * 1024 + (ob ^ (((ob >> 9) & 1) << 5)); }
__host__ __device__ __forceinline__ void stage_rc(int b, int& R, int& C) { const int st = b / 1024, sb = b % 1024, swz = sb ^ (((sb >> 9) & 1) << 5); R = (st >> 1) * 16 + swz / 64; C = (st & 1) * 32 + (swz % 64) / 2; }
__host__ __device__ __forceinline__ int perm32(int rho) { const int n = rho >> 4, i = rho & 15; return 8 * (i >> 2) + 4 * n + (i & 3); }

struct Unit { int pm, pn, k0, nt, kp; };
struct Gemm { const bf16_t* A; const bf16_t* Bt; int M, N, K; };

struct StaticOrder {
    int nM, nN, nwg, G, c, ntK;
    __host__ __device__ void init(int M, int N, int G_, int c_, int K_) { nM = M / BM; nN = N / BM; nwg = nM * nN; G = G_; c = c_; ntK = K_ / BK; }
    __host__ __device__ bool next(int i, Unit& u) const {
        const long L = (long)i * G + c; if (L >= nwg) return false;
        int wgid = (int)L; { const int q = nwg / NXCD, r = nwg % NXCD, xcd = wgid % NXCD, off = wgid / NXCD; wgid = (xcd < r ? xcd * (q + 1) : r * (q + 1) + (xcd - r) * q) + off; }
        const int nig = WGM * nN, gid = wgid / nig, fm = gid * WGM, gsz = (nM - fm) < WGM ? (nM - fm) : WGM;
        u.pm = fm + ((wgid % nig) % gsz); u.pn = (wgid % nig) / gsz; u.k0 = 0; u.nt = ntK; u.kp = -1; return true;
    }
    __device__ __forceinline__ void a_ready(const Unit&) const {}
    __device__ __forceinline__ void done(const Unit&) const {}
};

struct TailOrder {
    StaticOrder so; int nTailM, nsplit, ntPiece, nMain, G, c;
    __host__ __device__ void init(int Mmain, int Mtail, int N, int G_, int c_, int K_, int nsplit_) { so.init(Mmain, N, G_, c_, K_); nMain = so.nwg; nTailM = Mtail / BM; nsplit = nsplit_; ntPiece = (K_ / BK) / nsplit_; G = G_; c = c_; }
    __host__ __device__ bool next(int i, Unit& u) const {
        const long L = (long)i * G + c;
        if (L < nMain) return so.next(i, u);
        const int sidx = (int)(L - nMain); if (sidx >= nTailM * so.nN * nsplit) return false;
        const int tile = sidx / nsplit, kp = sidx % nsplit; u.pm = so.nM + tile / so.nN; u.pn = tile % so.nN; u.k0 = kp * ntPiece * BK; u.nt = ntPiece; u.kp = kp; return true;
    }
    __device__ __forceinline__ void a_ready(const Unit&) const {}
    __device__ __forceinline__ void done(const Unit&) const {}
};
__device__ __forceinline__ unsigned cvt_pk_bf16(float lo, float hi) { unsigned r; asm volatile("v_cvt_pk_bf16_f32 %0, %1, %2" : "=v"(r) : "v"(lo), "v"(hi)); return r; }
typedef float f32x2 __attribute__((ext_vector_type(2)));
__device__ __forceinline__ float silu_f(float x) { return x * __builtin_amdgcn_rcpf(1.f + __expf(-x)); }
__device__ __forceinline__ float sigmoid_f(float x) { return __builtin_amdgcn_rcpf(1.f + __expf(-x)); }
constexpr int E_TP = 32768, E_T = 33792;
struct EpiSwiGLU {
    static constexpr bool PERM = true, AFTER_DRAIN = false;
    bf16_t* O; int ldc;
    __device__ __forceinline__ void operator()(const f32x4 (&acc)[2][2][4][2], const Unit& u, int wr, int wc, int fr, int fq) const {
        const int row0 = u.pm * BM + wr * 64 + fr; const int col0 = u.pn * HALF + wc * 32 + 8 * fq;
#pragma unroll
        for (int ai = 0; ai < 2; ++ai)
#pragma unroll
            for (int m = 0; m < 4; ++m) { const int rr = wr * 64 + fr + ai * HALF + m * 16;
                bf16_t* rowp = O + (size_t)u.pm * 256 * ldc + (size_t)(col0 >> 6) * 16384 + rr * 64 + (col0 & 63);
                const f32x4 g0 = acc[ai][0][m][0], g1 = acc[ai][0][m][1], u0 = acc[ai][1][m][0], u1 = acc[ai][1][m][1];
                float v[8];
#pragma unroll
                for (int j = 0; j < 4; ++j) { v[j] = silu_f(g0[j]) * u0[j]; v[4 + j] = silu_f(g1[j]) * u1[j]; }
                u32x4 w; w.x = cvt_pk_bf16(v[0], v[1]); w.y = cvt_pk_bf16(v[2], v[3]); w.z = cvt_pk_bf16(v[4], v[5]); w.w = cvt_pk_bf16(v[6], v[7]);
                *(u32x4*)rowp = w; }
    }
};
struct EpiZ {
    static constexpr bool PERM = true, AFTER_DRAIN = false;
    bf16_t* Z; float* kp; float* ks; bf16_t* KF;
    __device__ __forceinline__ void operator()(const f32x4 (&acc)[2][2][4][2], const Unit& u, int wr, int wc, int fr, int fq) const {
        const int row0 = u.pm * BM + wr * 64 + fr; const int colt = u.pn * BM + wc * 32 + 8 * fq;
        const bool sig = (u.pn >= 10);
        const bool kout = (u.pn == 2 || u.pn == 3) && (u.pm >= 128 || (u.pm & 63) >= 62);
#pragma unroll
        for (int ai = 0; ai < 2; ++ai)
#pragma unroll
            for (int m = 0; m < 4; ++m) { const int row = row0 + ai * HALF + m * 16;
#pragma unroll
                for (int bj = 0; bj < 2; ++bj) { const int col = colt + bj * HALF; f32x4 v0 = acc[ai][bj][m][0], v1 = acc[ai][bj][m][1];
                    if (sig) {
#pragma unroll
                        for (int j = 0; j < 4; ++j) { v0[j] = sigmoid_f(v0[j]); v1[j] = sigmoid_f(v1[j]); } }
                    u32x4 w; w.x = cvt_pk_bf16(v0[0], v0[1]); w.y = cvt_pk_bf16(v0[2], v0[3]); w.z = cvt_pk_bf16(v1[0], v1[1]); w.w = cvt_pk_bf16(v1[2], v1[3]);
                    if (u.pn == 2 || u.pn == 3) { const int cc = col - 512, hh = cc >> 6, dd = cc & 63;
                        *(u32x4*)(KF + ((((size_t)(row >> 5) * 8 + hh) * 4 + (dd >> 4)) * 64 + ((dd >> 3) & 1) * 32 + (row & 31)) * 8) = w; }
                    else *(u32x4*)(Z + (size_t)row * 3072 + col) = w;
                    if (kout) { float* dst = (u.pm >= 128) ? ks + (size_t)(row - E_TP) * 512 + (col - 512)
                                                           : kp + (size_t)((row >> 14) * 512 + ((row & 16383) - 15872)) * 512 + (col - 512);
                        *(f32x4*)dst = v0; *(f32x4*)(dst + 4) = v1; } } }
    }
};
struct EpiVT {
    static constexpr bool PERM = true, AFTER_DRAIN = false;
    bf16_t* VT; float* vp; float* vs;
    __device__ __forceinline__ void operator()(const f32x4 (&acc)[2][2][4][2], const Unit& u, int wr, int wc, int fr, int fq) const {
        const int row0 = u.pm * BM + wr * 64 + fr; const int colt = u.pn * BM + wc * 32 + 8 * fq;
        const bool vout = (u.pn >= 128 || (u.pn & 63) >= 62);
#pragma unroll
        for (int ai = 0; ai < 2; ++ai)
#pragma unroll
            for (int m = 0; m < 4; ++m) { const int row = row0 + ai * HALF + m * 16;
#pragma unroll
                for (int bj = 0; bj < 2; ++bj) { const int col = colt + bj * HALF; const f32x4 v0 = acc[ai][bj][m][0], v1 = acc[ai][bj][m][1];
                    u32x4 w; w.x = cvt_pk_bf16(v0[0], v0[1]); w.y = cvt_pk_bf16(v0[2], v0[3]); w.z = cvt_pk_bf16(v1[0], v1[1]); w.w = cvt_pk_bf16(v1[2], v1[3]);
                    { const int hh = row >> 6, dd = row & 63, tl = col & 31;
                      bf16_t* dst = VT + ((((((size_t)(col >> 5) * 8 + hh) * 2 + (dd >> 5)) * 2 + (tl >> 4)) * 64 + (dd & 31)) * 8) + ((tl >> 3) & 1) * 4;
                      u32x2 w0; w0.x = w.x; w0.y = w.y; u32x2 w1; w1.x = w.z; w1.y = w.w;
                      *(u32x2*)dst = w0; *(u32x2*)(dst + 32 * 8) = w1; }
                    if (vout) {
#pragma unroll
                        for (int j = 0; j < 8; ++j) { const int tok = col + j; const float val = j < 4 ? v0[j & 3] : v1[j & 3];
                            float* dst = (u.pn >= 128) ? vs + (size_t)(tok - E_TP) * 512 + row
                                                       : vp + (size_t)((tok >> 14) * 512 + ((tok & 16383) - 15872)) * 512 + row;
                            *dst = val; } } } }
    }
};
struct EpiResIn {
    static constexpr bool PERM = false, AFTER_DRAIN = false; static constexpr float scale = 0.5f;
    const float* xp; const float* xs; bf16_t* outb; float* slab;
    __device__ __forceinline__ void operator()(const f32x4 (&acc)[2][2][4][2], const Unit& u, int wr, int wc, int fr, int fq) const {
        const int row0 = u.pm * BM + wr * 64 + fr; const int col0 = u.pn * BM + wc * 32 + 4 * fq;
        if (u.kp >= 0) {
#pragma unroll
            for (int ai = 0; ai < 2; ++ai)
#pragma unroll
                for (int m = 0; m < 4; ++m) { const int row = row0 + ai * HALF + m * 16; float* sp = slab + ((size_t)u.kp * 1024 + (row - E_TP)) * 1024;
#pragma unroll
                    for (int bj = 0; bj < 2; ++bj)
#pragma unroll
                        for (int n = 0; n < 2; ++n) *(f32x4*)(sp + col0 + bj * HALF + n * 16) = acc[ai][bj][m][n] * scale; }
            return; }
#pragma unroll
        for (int ai = 0; ai < 2; ++ai) { f32x4 b[4][2][2];
#pragma unroll
            for (int m = 0; m < 4; ++m) { const int row = row0 + ai * HALF + m * 16;
                const float* bp = row < E_TP ? xp + (size_t)row * 1024 : xs + (size_t)(row - E_TP) * 1024;
#pragma unroll
                for (int bj = 0; bj < 2; ++bj)
#pragma unroll
                    for (int n = 0; n < 2; ++n) b[m][bj][n] = *(const f32x4*)(bp + col0 + bj * HALF + n * 16); }
            asm volatile("" ::: "memory");
#pragma unroll
            for (int m = 0; m < 4; ++m) { bf16_t* op = outb + (size_t)(row0 + ai * HALF + m * 16) * 1024;
#pragma unroll
                for (int bj = 0; bj < 2; ++bj)
#pragma unroll
                    for (int n = 0; n < 2; ++n) { const f32x4 o = b[m][bj][n] + acc[ai][bj][m][n] * scale; u32x2 w; w.x = cvt_pk_bf16(o[0], o[1]); w.y = cvt_pk_bf16(o[2], o[3]);
                        *(u32x2*)(op + col0 + bj * HALF + n * 16) = w; } }
            asm volatile("" ::: "memory"); }
    }
};
template <int SC2> struct EpiResB {
    static constexpr bool PERM = false, AFTER_DRAIN = false; static constexpr float scale = 0.5f * SC2;
    const bf16_t* base; bf16_t* outb; float* slab;
    __device__ __forceinline__ void operator()(const f32x4 (&acc)[2][2][4][2], const Unit& u, int wr, int wc, int fr, int fq) const {
        const int row0 = u.pm * BM + wr * 64 + fr; const int col0 = u.pn * BM + wc * 32 + 4 * fq;
        if (u.kp >= 0) {
#pragma unroll
            for (int ai = 0; ai < 2; ++ai)
#pragma unroll
                for (int m = 0; m < 4; ++m) { const int row = row0 + ai * HALF + m * 16; float* sp = slab + ((size_t)u.kp * 1024 + (row - E_TP)) * 1024;
#pragma unroll
                    for (int bj = 0; bj < 2; ++bj)
#pragma unroll
                        for (int n = 0; n < 2; ++n) *(f32x4*)(sp + col0 + bj * HALF + n * 16) = acc[ai][bj][m][n] * scale; }
            return; }
        u32x2 b[2][4][2][2];
#pragma unroll
        for (int ai = 0; ai < 2; ++ai)
#pragma unroll
            for (int m = 0; m < 4; ++m) { const bf16_t* bp = base + (size_t)(row0 + ai * HALF + m * 16) * 1024;
#pragma unroll
                for (int bj = 0; bj < 2; ++bj)
#pragma unroll
                    for (int n = 0; n < 2; ++n) b[ai][m][bj][n] = *(const u32x2*)(bp + col0 + bj * HALF + n * 16); }
        asm volatile("" ::: "memory");
#pragma unroll
        for (int ai = 0; ai < 2; ++ai)
#pragma unroll
            for (int m = 0; m < 4; ++m) { bf16_t* op = outb + (size_t)(row0 + ai * HALF + m * 16) * 1024;
#pragma unroll
                for (int bj = 0; bj < 2; ++bj)
#pragma unroll
                    for (int n = 0; n < 2; ++n) { const u32x2 bb = b[ai][m][bj][n]; f32x4 o;
                        o[0] = __uint_as_float(bb.x << 16); o[1] = __uint_as_float(bb.x & 0xffff0000u); o[2] = __uint_as_float(bb.y << 16); o[3] = __uint_as_float(bb.y & 0xffff0000u);
                        o = o + acc[ai][bj][m][n] * scale; u32x2 w; w.x = cvt_pk_bf16(o[0], o[1]); w.y = cvt_pk_bf16(o[2], o[3]);
                        *(u32x2*)(op + col0 + bj * HALF + n * 16) = w; } }
    }
};
template <int SC2> struct EpiRes {
    static constexpr bool PERM = false, AFTER_DRAIN = false; static constexpr float scale = 0.5f * SC2;
    const float* xp; const float* xs; float* out; float* slab;
    __device__ __forceinline__ void operator()(const f32x4 (&acc)[2][2][4][2], const Unit& u, int wr, int wc, int fr, int fq) const {
        const int row0 = u.pm * BM + wr * 64 + fr; const int col0 = u.pn * BM + wc * 32 + 4 * fq;
        if (u.kp >= 0) {
#pragma unroll
            for (int ai = 0; ai < 2; ++ai)
#pragma unroll
                for (int m = 0; m < 4; ++m) { const int row = row0 + ai * HALF + m * 16; float* sp = slab + ((size_t)u.kp * 1024 + (row - E_TP)) * 1024;
#pragma unroll
                    for (int bj = 0; bj < 2; ++bj)
#pragma unroll
                        for (int n = 0; n < 2; ++n) *(f32x4*)(sp + col0 + bj * HALF + n * 16) = acc[ai][bj][m][n] * scale; }
            return; }
#pragma unroll
        for (int ai = 0; ai < 2; ++ai) { f32x4 b[4][2][2];
#pragma unroll
            for (int m = 0; m < 4; ++m) { const int row = row0 + ai * HALF + m * 16;
                const float* bp = xp ? (row < E_TP ? xp + (size_t)row * 1024 : xs + (size_t)(row - E_TP) * 1024) : out + (size_t)row * 1024;
#pragma unroll
                for (int bj = 0; bj < 2; ++bj)
#pragma unroll
                    for (int n = 0; n < 2; ++n) b[m][bj][n] = *(const f32x4*)(bp + col0 + bj * HALF + n * 16); }
            asm volatile("" ::: "memory");
#pragma unroll
            for (int m = 0; m < 4; ++m) { float* op = out + (size_t)(row0 + ai * HALF + m * 16) * 1024;
#pragma unroll
                for (int bj = 0; bj < 2; ++bj)
#pragma unroll
                    for (int n = 0; n < 2; ++n) *(f32x4*)(op + col0 + bj * HALF + n * 16) = b[m][bj][n] + acc[ai][bj][m][n] * scale; }
            asm volatile("" ::: "memory"); }
    }
};
template <class Epi, class Sched, bool ALIGN_EPI = false, bool SP2 = false, bool PK = false>
__device__ __forceinline__ void gemm_phase(PG8_LAS unsigned char* lds, const Gemm g, const Sched& S, const Epi& E) {
    const int tid = threadIdx.x, wid = __builtin_amdgcn_readfirstlane(tid >> 6), lane = tid & 63, wr = wid >> 2, wc = wid & 3, fr = lane & 15, fq = lane >> 4;
    const int K = g.K;
    unsigned voffA[2], voffB[2];
#pragma unroll
    for (int i = 0; i < 2; ++i) { int R, C; stage_rc(tid * 16 + i * 8192, R, C); const int Rb = Epi::PERM ? ((R & ~31) + perm32(R & 31)) : R;
        voffA[i] = (unsigned)(R * (PK ? BK : K) + C) * 2u; voffB[i] = (unsigned)(Rb * (PK ? BK : K) + C) * 2u; }
    const size_t kstep = PK ? (size_t)(BM * BK * 2) : (size_t)(BK * 2);
    const size_t hstep = PK ? (size_t)(HALF * BK * 2) : (size_t)HALF * K * 2;
    const size_t tstep = (size_t)BM * K * 2;
    const unsigned ldsw = (unsigned)wid * 1024u;
    const int aoff = lds_byte(wr * 64 + fr, fq * 8), boff = lds_byte(wc * 32 + fr, fq * 8);
#define PG8_SA(b, h) (((b) * 2 + (h)) * HTB)
#define PG8_SB(b, h) ((4 + (b) * 2 + (h)) * HTB)
#define PG8_STAGE(bufoff, gbase, voff) do { _Pragma("unroll") for (int _i = 0; _i < 2; ++_i) \
        __builtin_amdgcn_global_load_lds((const unsigned*)((const char*)(gbase) + (voff)[_i]), (PG8_LAS unsigned*)(lds + (bufoff) + ldsw + _i * 8192), 16, 0, 0); } while (0)
#define PG8_LDA(dst, b, h) do { _Pragma("unroll") for (int m = 0; m < 4; ++m) _Pragma("unroll") for (int k = 0; k < 2; ++k) dst[m][k] = *(const PG8_LAS bf16x8*)(lds + PG8_SA(b, h) + aoff + m * 2048 + k * 1024); } while (0)
#define PG8_LDB(dst, b, h) do { _Pragma("unroll") for (int n = 0; n < 2; ++n) _Pragma("unroll") for (int k = 0; k < 2; ++k) dst[n][k] = *(const PG8_LAS bf16x8*)(lds + PG8_SB(b, h) + boff + n * 2048 + k * 1024); } while (0)
#define PG8_MMA(ai, bj, At, Bt) do { __builtin_amdgcn_s_setprio(1); _Pragma("unroll") for (int m = 0; m < 4; ++m) _Pragma("unroll") for (int n = 0; n < 2; ++n) _Pragma("unroll") for (int k = 0; k < 2; ++k) \
        acc[ai][bj][m][n] = __builtin_amdgcn_mfma_f32_16x16x32_bf16(Bt[n][k], At[m][k], acc[ai][bj][m][n], 0, 0, 0); __builtin_amdgcn_s_setprio(0); } while (0)
#define PG8_WAIT_V(n) asm volatile("s_waitcnt vmcnt(" #n ")" ::: "memory")
#define PG8_WAIT_L(n) asm volatile("s_waitcnt lgkmcnt(" #n ")" ::: "memory")
#define PG8_BAR __builtin_amdgcn_s_barrier()
#define PG8_SCHED __builtin_amdgcn_sched_barrier(0)
    Unit cur, nxt; int ui = 0;
    if (!S.next(0, cur)) return;
    f32x4 acc[2][2][4][2];
#pragma unroll
    for (int a = 0; a < 2; ++a)
#pragma unroll
        for (int b = 0; b < 2; ++b)
#pragma unroll
            for (int m = 0; m < 4; ++m)
#pragma unroll
                for (int n = 0; n < 2; ++n) acc[a][b][m][n] = (f32x4){0.f, 0.f, 0.f, 0.f};
    bf16x8 At[4][2], B0[2][2], B1[2][2];
    const char* cA = (const char*)g.A + (size_t)cur.pm * tstep + (PK ? (size_t)(cur.k0 / BK) * kstep : (size_t)cur.k0 * 2); const char* cB = (const char*)g.Bt + (size_t)cur.pn * tstep + (PK ? (size_t)(cur.k0 / BK) * kstep : (size_t)cur.k0 * 2);
    S.a_ready(cur);
    if constexpr (SP2) {
        PG8_STAGE(PG8_SB(0, 0), cB, voffB); PG8_STAGE(PG8_SB(0, 1), cB + hstep, voffB); PG8_STAGE(PG8_SA(0, 0), cA, voffA); PG8_STAGE(PG8_SA(0, 1), cA + hstep, voffA);
        if (wr == 1) PG8_BAR;
        PG8_WAIT_V(2); PG8_BAR;
        PG8_STAGE(PG8_SB(1, 0), cB + kstep, voffB); PG8_STAGE(PG8_SA(1, 0), cA + kstep, voffA); PG8_STAGE(PG8_SB(1, 1), cB + hstep + kstep, voffB);
        PG8_WAIT_V(6); PG8_BAR;
    } else {
        PG8_STAGE(PG8_SB(0, 0), cB, voffB); PG8_STAGE(PG8_SA(0, 0), cA, voffA); PG8_STAGE(PG8_SB(0, 1), cB + hstep, voffB); PG8_STAGE(PG8_SA(0, 1), cA + hstep, voffA);
        if (wr == 1) PG8_BAR;
        PG8_WAIT_V(4); PG8_BAR;
        PG8_STAGE(PG8_SB(1, 0), cB + kstep, voffB); PG8_STAGE(PG8_SA(1, 0), cA + kstep, voffA); PG8_STAGE(PG8_SB(1, 1), cB + hstep + kstep, voffB);
        PG8_WAIT_V(6); PG8_BAR;
    }
    for (;;) {
        const bool has_next = S.next(ui + 1, nxt);
        const char* nA = has_next ? (const char*)g.A + (size_t)nxt.pm * tstep + (PK ? (size_t)(nxt.k0 / BK) * kstep : (size_t)nxt.k0 * 2) : cA; const char* nB = has_next ? (const char*)g.Bt + (size_t)nxt.pn * tstep + (PK ? (size_t)(nxt.k0 / BK) * kstep : (size_t)nxt.k0 * 2) : cB;
        const int nt = cur.nt;
        for (int t = 0; t < nt; t += 2) {
            const bool last = (t == nt - 2);
            const char* a1 = cA + (size_t)(t + 1) * kstep;
            const char* a2 = last ? nA : cA + (size_t)(t + 2) * kstep; const char* b2 = last ? nB : cB + (size_t)(t + 2) * kstep;
            const char* a3 = a2 + kstep; const char* b3 = b2 + kstep;
            if (last && has_next) S.a_ready(nxt);
            if constexpr (SP2) {
            PG8_LDB(B0, 0, 0); PG8_LDB(B1, 0, 1); PG8_SCHED; PG8_LDA(At, 0, 0); PG8_STAGE(PG8_SA(1, 1), a1 + hstep, voffA);
            PG8_WAIT_V(8); PG8_WAIT_L(0); PG8_BAR; PG8_MMA(0, 0, At, B0); PG8_MMA(0, 1, At, B1); PG8_BAR; PG8_SCHED;
            PG8_LDA(At, 0, 1); PG8_STAGE(PG8_SB(0, 0), b2, voffB); PG8_STAGE(PG8_SB(0, 1), b2 + hstep, voffB); PG8_STAGE(PG8_SA(0, 0), a2, voffA);
            PG8_WAIT_V(8); PG8_WAIT_L(0); PG8_BAR; PG8_MMA(1, 0, At, B0); PG8_MMA(1, 1, At, B1); PG8_BAR; PG8_SCHED;
            PG8_LDB(B0, 1, 0); PG8_LDB(B1, 1, 1); PG8_SCHED; PG8_LDA(At, 1, 0); PG8_STAGE(PG8_SA(0, 1), a2 + hstep, voffA);
            PG8_WAIT_V(8); PG8_WAIT_L(0); PG8_BAR; PG8_MMA(0, 0, At, B0); PG8_MMA(0, 1, At, B1); PG8_BAR; PG8_SCHED;
            PG8_LDA(At, 1, 1); PG8_STAGE(PG8_SB(1, 0), b3, voffB); PG8_STAGE(PG8_SB(1, 1), b3 + hstep, voffB); PG8_STAGE(PG8_SA(1, 0), a3, voffA);
            PG8_WAIT_V(8); PG8_WAIT_L(0); PG8_BAR; PG8_MMA(1, 0, At, B0); PG8_MMA(1, 1, At, B1); PG8_BAR; PG8_SCHED;
            } else {
            PG8_LDB(B0, 0, 0); PG8_SCHED; PG8_LDA(At, 0, 0); PG8_STAGE(PG8_SA(1, 1), a1 + hstep, voffA);
            PG8_WAIT_L(8); PG8_BAR; PG8_WAIT_L(0); PG8_MMA(0, 0, At, B0); PG8_BAR; PG8_SCHED;
            PG8_LDB(B1, 0, 1); PG8_STAGE(PG8_SB(0, 0), b2, voffB);
            PG8_BAR; PG8_WAIT_L(0); PG8_MMA(0, 1, At, B1); PG8_BAR;
            PG8_LDA(At, 0, 1); PG8_STAGE(PG8_SA(0, 0), a2, voffA);
            PG8_BAR; PG8_WAIT_L(0); PG8_MMA(1, 0, At, B0); PG8_BAR; PG8_SCHED;
            PG8_STAGE(PG8_SB(0, 1), b2 + hstep, voffB);
            PG8_WAIT_V(6); PG8_BAR; PG8_MMA(1, 1, At, B1); PG8_BAR;
            PG8_LDB(B0, 1, 0); PG8_SCHED; PG8_LDA(At, 1, 0); PG8_STAGE(PG8_SA(0, 1), a2 + hstep, voffA);
            PG8_WAIT_L(8); PG8_BAR; PG8_WAIT_L(0); PG8_MMA(0, 0, At, B0); PG8_BAR; PG8_SCHED;
            PG8_LDB(B1, 1, 1); PG8_STAGE(PG8_SB(1, 0), b3, voffB);
            PG8_BAR; PG8_WAIT_L(0); PG8_MMA(0, 1, At, B1); PG8_BAR;
            PG8_LDA(At, 1, 1); PG8_STAGE(PG8_SA(1, 0), a3, voffA);
            PG8_BAR; PG8_WAIT_L(0); PG8_MMA(1, 0, At, B0); PG8_BAR; PG8_SCHED;
            PG8_STAGE(PG8_SB(1, 1), b3 + hstep, voffB);
            PG8_WAIT_V(6); PG8_BAR; PG8_MMA(1, 1, At, B1); PG8_BAR;
            }
        }
        if constexpr (ALIGN_EPI) { if (wr == 0) PG8_BAR; }
        if constexpr (!Epi::AFTER_DRAIN) { E(acc, cur, wr, wc, fr, fq); S.done(cur); }
        if (!has_next) break;
#pragma unroll
        for (int a = 0; a < 2; ++a)
#pragma unroll
            for (int b = 0; b < 2; ++b)
#pragma unroll
                for (int m = 0; m < 4; ++m)
#pragma unroll
                    for (int n = 0; n < 2; ++n) acc[a][b][m][n] = (f32x4){0.f, 0.f, 0.f, 0.f};
        cur = nxt; cA = nA; cB = nB; ++ui;
        if constexpr (ALIGN_EPI) { if (wr == 1) PG8_BAR; }
    }
    PG8_WAIT_V(0);
    if constexpr (!ALIGN_EPI) { if (wr == 0) PG8_BAR; }
    PG8_BAR;
    if constexpr (Epi::AFTER_DRAIN) { E.fused(acc, cur, wr, wc, fr, fq, lds, wid, lane); S.done(cur); }
#undef PG8_SA
#undef PG8_SB
#undef PG8_STAGE
#undef PG8_LDA
#undef PG8_LDB
#undef PG8_MMA
#undef PG8_WAIT_V
#undef PG8_WAIT_L
#undef PG8_BAR
#undef PG8_SCHED
}
}
#define LAS __attribute__((address_space(3)))
typedef unsigned short bf16;
typedef short bf16x8 __attribute__((ext_vector_type(8)));
typedef float f32x4 __attribute__((ext_vector_type(4)));
typedef float f32x16 __attribute__((ext_vector_type(16)));
typedef unsigned u32x4 __attribute__((ext_vector_type(4)));
typedef unsigned u32x2 __attribute__((ext_vector_type(2)));
typedef float f32x2_t __attribute__((ext_vector_type(2)));
typedef __bf16 bf16x2_t __attribute__((ext_vector_type(2)));

constexpr int TP = 32768, TS = 1024, T = TP + TS, DM = 1024, FF = 2816, NZ = 3072;
constexpr int NU_P = 2048, NU_S = 128, NU = NU_P + NU_S;
constexpr int NWAVES = 8, NTHR = 512;
constexpr size_t MiB = 1u << 20;
constexpr size_t WS_CTL = 0, CTL_BYTES = 1 * MiB;
constexpr size_t WS_W13A = 2 * MiB, WS_W2A = 13 * MiB, WS_WIN = 19 * MiB, WS_WV = 25 * MiB, WS_WOUT = 26 * MiB, WS_W13B = 28 * MiB, WS_W2B = 39 * MiB;
constexpr size_t WS_H = 46 * MiB;
constexpr size_t WS_BIG = 112 * MiB;
constexpr size_t WS_VT = 310 * MiB;
constexpr size_t WS_G = 343 * MiB;
constexpr size_t WS_QC = 345 * MiB, WS_KC = 378 * MiB;
constexpr size_t WS_DC = 411 * MiB;
constexpr size_t WS_DN = 46661632;
constexpr size_t WS_SC = WS_DN + 1114112;
constexpr size_t WS_KF = 479 * MiB;
constexpr size_t WS_END = 512 * MiB;
constexpr size_t O_Y = 0, O_KP = 34603008, O_VP = 35127296, O_CP = 35651584, O_NP = 35782656, O_MP = 35783680, O_CVP = 35783688,
                 O_KS = 35789832, O_VS = 36314120, O_CS = 36838408, O_NS = 38935560, O_MS = 38951944, O_CVS = 38952072, O_END = 39050376;
constexpr int LDS_BYTES = 147456;

__device__ __forceinline__ unsigned pk2(float lo, float hi) { f32x2_t v = {lo, hi}; bf16x2_t b = __builtin_convertvector(v, bf16x2_t); return __builtin_bit_cast(unsigned, b); }
__device__ __forceinline__ float bflo(unsigned u) { return __uint_as_float(u << 16); }
__device__ __forceinline__ float bfhi(unsigned u) { return __uint_as_float(u & 0xffff0000u); }
__device__ __forceinline__ float bf2f(bf16 b) { return __uint_as_float((unsigned)b << 16); }
__device__ __forceinline__ bf16 f2bf(float f) { return (bf16)(pk2(f, 0.f) & 0xffffu); }
__device__ __forceinline__ float wave_sum(float v) {
#pragma unroll
    for (int o = 1; o < 64; o <<= 1) v += __shfl_xor(v, o);
    return v;
}
__device__ __forceinline__ float wave_max(float v) {
#pragma unroll
    for (int o = 1; o < 64; o <<= 1) v = fmaxf(v, __shfl_xor(v, o));
    return v;
}
__device__ __forceinline__ int crow(int r, int hi) { return (r & 3) + 8 * (r >> 2) + 4 * hi; }
#define MFMA32(a, b, c) __builtin_amdgcn_mfma_f32_32x32x16_bf16((a), (b), (c), 0, 0, 0)
__device__ __forceinline__ bf16x8 pack8f(const float* x) { u32x4 p; p.x = pk2(x[0], x[1]); p.y = pk2(x[2], x[3]); p.z = pk2(x[4], x[5]); p.w = pk2(x[6], x[7]); return __builtin_bit_cast(bf16x8, p); }
__device__ __forceinline__ float silu(float x) { return x * __builtin_amdgcn_rcpf(1.f + __expf(-x)); }
__device__ __forceinline__ float log_sigmoid(float x) { return fminf(x, 0.f) - log1pf(__expf(-fabsf(x))); }

__device__ __forceinline__ void transpose_item(const float* W, int ldn, int K, bf16* WTrow0, int k0, int n0, LAS float* scr, int lane, bool packed = false) {
#pragma unroll 8
    for (int i = 0; i < 32; ++i) { const int kk = 2 * i + (lane >> 5); scr[kk * 33 + (lane & 31)] = W[(size_t)(k0 + kk) * ldn + n0 + (lane & 31)]; }
    asm volatile("s_waitcnt lgkmcnt(0)" ::: "memory");
    const int c = lane & 7;
#pragma unroll
    for (int j = 0; j < 4; ++j) { const int n = (lane >> 3) + 8 * j; const LAS float* s = scr + (8 * c) * 33 + n;
        u32x4 o; o.x = pk2(s[0 * 33], s[1 * 33]); o.y = pk2(s[2 * 33], s[3 * 33]); o.z = pk2(s[4 * 33], s[5 * 33]); o.w = pk2(s[6 * 33], s[7 * 33]);
        if (packed) *(u32x4*)(WTrow0 + (size_t)(n0 >> 8) * 256 * K + (size_t)(k0 >> 6) * 16384 + ((n0 & 255) + n) * 64 + 8 * c) = o;
        else *(u32x4*)(WTrow0 + (size_t)n * K + k0 + 8 * c) = o; }
    asm volatile("s_waitcnt lgkmcnt(0)" ::: "memory");
}
struct Ptrs { const float* in[25]; float* out; unsigned char* ws; int ph_lo, ph_hi, coop, pad; };

__device__ __forceinline__ void p0_weights(const Ptrs& P, LAS float* scr, int gw, int NGW, int lane, int it_lo, int it_hi, int it_skip_lo, int it_skip_hi) {
    constexpr int I_F = 1408, I_IN = 1792, I_OUT = 512;
    constexpr int NIT = 6 * I_F + I_IN + I_OUT;
    unsigned char* ws = P.ws;
    for (int it0 = it_lo + gw; it0 < it_hi; it0 += NGW) {
        const int it = it0 >= it_skip_lo ? it0 + (it_skip_hi - it_skip_lo) : it0; if (it >= NIT) break;
        int r = it;
        if (r < 6 * I_F) {
            const int f = r / (3 * I_F); r -= f * 3 * I_F;
            const int mt = r / I_F; r -= mt * I_F;
            bf16* W13 = (bf16*)(ws + (f ? WS_W13B : WS_W13A)); bf16* W2 = (bf16*)(ws + (f ? WS_W2B : WS_W2A));
            const int base = f ? 21 : 9;
            if (mt < 2) { const int kb = r / 88, nb = r % 88, n0 = nb * 32;
                transpose_item(P.in[base + mt], FF, DM, W13 + (size_t)((n0 >> 7) * 256 + mt * 128 + (n0 & 127)) * DM, kb * 64, n0, scr, lane); }
            else { const int kb = r / 32, nb = r % 32, n0 = nb * 32;
                transpose_item(P.in[base + 2], DM, FF, W2, kb * 64, n0, scr, lane, true); }
            continue;
        }
        r -= 6 * I_F;
        if (r < I_IN) { const int kb = r / 112, nb = r % 112, n0 = nb * 32;
            bf16* dst = n0 < 1024 ? (bf16*)(ws + WS_WIN) + (size_t)n0 * DM : n0 < 1536 ? (bf16*)(ws + WS_WV) + (size_t)(n0 - 1024) * DM : (bf16*)(ws + WS_WIN) + (size_t)(n0 - 512) * DM;
            transpose_item(P.in[13], 3592, DM, dst, kb * 64, n0, scr, lane); continue; }
        r -= I_IN;
        { const int kb = r / 32, nb = r % 32, n0 = nb * 32; transpose_item(P.in[19], DM, DM, (bf16*)(ws + WS_WOUT) + (size_t)n0 * DM, kb * 64, n0, scr, lane); }
    }
}

template <int MODE>
__device__ __forceinline__ void rms_rows(const float* xp, const float* xs, const float* gain, bf16* H, float* outf, const LAS float* gwl, const float* gbias, float* G, int gw, int NGW, int lane, const float* slab, int nsplit, float* xwb) {
    f32x4 g[4];
#pragma unroll
    for (int j = 0; j < 4; ++j) g[j] = ((const f32x4*)gain)[lane + 64 * j];
    f32x4 vn[4];
    if (gw < T) { const float* xr0 = (xs && gw >= TP) ? xs + (size_t)(gw - TP) * DM : xp + (size_t)gw * DM;
#pragma unroll
        for (int j = 0; j < 4; ++j) vn[j] = ((const f32x4*)xr0)[lane + 64 * j]; }
    for (int m = gw; m < T; m += NGW) {
        f32x4 v[4]; float s = 0.f;
#pragma unroll
        for (int j = 0; j < 4; ++j) v[j] = vn[j];
        { const int mn = m + NGW; if (mn < T) { const float* xrn = (xs && mn >= TP) ? xs + (size_t)(mn - TP) * DM : xp + (size_t)mn * DM;
#pragma unroll
            for (int j = 0; j < 4; ++j) vn[j] = ((const f32x4*)xrn)[lane + 64 * j]; } }
        if (nsplit && m >= TP) {
            for (int kp = 0; kp < nsplit; ++kp) { const f32x4* sp = (const f32x4*)(slab + ((size_t)kp * 1024 + (m - TP)) * DM);
#pragma unroll
                for (int j = 0; j < 4; ++j) v[j] += sp[lane + 64 * j]; }
            if (MODE != 2) {
#pragma unroll
                for (int j = 0; j < 4; ++j) ((f32x4*)(xwb + (size_t)m * DM))[lane + 64 * j] = v[j]; }
        }
#pragma unroll
        for (int j = 0; j < 4; ++j) s += (v[j].x * v[j].x + v[j].y * v[j].y) + (v[j].z * v[j].z + v[j].w * v[j].w);
        s = wave_sum(s);
        const float rstd = 1.0f / sqrtf(s * (1.0f / DM) + 1e-6f);
#pragma unroll
        for (int j = 0; j < 4; ++j) v[j] = v[j] * rstd * g[j];
        if (MODE == 2) {
#pragma unroll
            for (int j = 0; j < 4; ++j) ((f32x4*)(outf + (size_t)m * DM))[lane + 64 * j] = v[j];
        } else {
#pragma unroll
            for (int j = 0; j < 4; ++j) { u32x2 w; w.x = pk2(v[j].x, v[j].y); w.y = pk2(v[j].z, v[j].w); ((u32x2*)(H + (size_t)m * DM))[lane + 64 * j] = w; }
        }
        if (MODE == 1) {
            float a8[8];
#pragma unroll
            for (int q = 0; q < 8; ++q) a8[q] = 0.f;
#pragma unroll
            for (int j = 0; j < 4; ++j)
#pragma unroll
                for (int i = 0; i < 4; ++i) { const LAS f32x4* wp = (const LAS f32x4*)(gwl + ((j * 4 + i) * 64 + lane) * 8); const f32x4 w0 = wp[0], w1 = wp[1]; const float xv = v[j][i];
                    a8[0] += xv * w0.x; a8[1] += xv * w0.y; a8[2] += xv * w0.z; a8[3] += xv * w0.w; a8[4] += xv * w1.x; a8[5] += xv * w1.y; a8[6] += xv * w1.z; a8[7] += xv * w1.w; }
#pragma unroll
            for (int q = 0; q < 8; ++q) a8[q] = wave_sum(a8[q]);
            float val = a8[0];
#pragma unroll
            for (int q = 1; q < 8; ++q) val = (lane == q) ? a8[q] : val;
            if (lane < 8) { val += gbias[lane]; if (lane >= 4) val = log_sigmoid(val); G[(size_t)m * 8 + lane] = val; }
        }
    }
}
template <int MODE>
__device__ __forceinline__ void rms_rows_b(bf16* XS, const float* gain, bf16* H, const LAS float* gwl, const float* gbias, float* G, int gw, int NGW, int lane, const float* slab, int nsplit, float* xsamp) {
    f32x4 g[4];
#pragma unroll
    for (int j = 0; j < 4; ++j) g[j] = ((const f32x4*)gain)[lane + 64 * j];
    u32x2 nb[4];
    if (gw < T) {
#pragma unroll
        for (int j = 0; j < 4; ++j) nb[j] = ((const u32x2*)(XS + (size_t)gw * DM))[lane + 64 * j]; }
    for (int m = gw; m < T; m += NGW) {
        f32x4 v[4]; float s = 0.f;
#pragma unroll
        for (int j = 0; j < 4; ++j) { v[j].x = bflo(nb[j].x); v[j].y = bfhi(nb[j].x); v[j].z = bflo(nb[j].y); v[j].w = bfhi(nb[j].y); }
        { const int mn = m + NGW; if (mn < T) {
#pragma unroll
            for (int j = 0; j < 4; ++j) nb[j] = ((const u32x2*)(XS + (size_t)mn * DM))[lane + 64 * j]; } }
        if (m >= TP) {
            for (int kp = 0; kp < nsplit; ++kp) { const f32x4* sp = (const f32x4*)(slab + ((size_t)kp * 1024 + (m - TP)) * DM);
#pragma unroll
                for (int j = 0; j < 4; ++j) v[j] += sp[lane + 64 * j]; }
#pragma unroll
            for (int j = 0; j < 4; ++j) { u32x2 w; w.x = pk2(v[j].x, v[j].y); w.y = pk2(v[j].z, v[j].w); ((u32x2*)(XS + (size_t)m * DM))[lane + 64 * j] = w;
                if (xsamp) ((f32x4*)(xsamp + (size_t)(m - TP) * DM))[lane + 64 * j] = v[j]; }
        }
#pragma unroll
        for (int j = 0; j < 4; ++j) s += (v[j].x * v[j].x + v[j].y * v[j].y) + (v[j].z * v[j].z + v[j].w * v[j].w);
        s = wave_sum(s);
        const float rstd = 1.0f / sqrtf(s * (1.0f / DM) + 1e-6f);
#pragma unroll
        for (int j = 0; j < 4; ++j) v[j] = v[j] * rstd * g[j];
#pragma unroll
        for (int j = 0; j < 4; ++j) { u32x2 w; w.x = pk2(v[j].x, v[j].y); w.y = pk2(v[j].z, v[j].w); ((u32x2*)(H + (size_t)m * DM))[lane + 64 * j] = w; }
        if (MODE == 1) {
            float a8[8];
#pragma unroll
            for (int q = 0; q < 8; ++q) a8[q] = 0.f;
#pragma unroll
            for (int j = 0; j < 4; ++j)
#pragma unroll
                for (int i = 0; i < 4; ++i) { const LAS f32x4* wp = (const LAS f32x4*)(gwl + ((j * 4 + i) * 64 + lane) * 8); const f32x4 w0 = wp[0], w1 = wp[1]; const float xv = v[j][i];
                    a8[0] += xv * w0.x; a8[1] += xv * w0.y; a8[2] += xv * w0.z; a8[3] += xv * w0.w; a8[4] += xv * w1.x; a8[5] += xv * w1.y; a8[6] += xv * w1.z; a8[7] += xv * w1.w; }
#pragma unroll
            for (int q = 0; q < 8; ++q) a8[q] = wave_sum(a8[q]);
            float val = a8[0];
#pragma unroll
            for (int q = 1; q < 8; ++q) val = (lane == q) ? a8[q] : val;
            if (lane < 8) { val += gbias[lane]; if (lane >= 4) val = log_sigmoid(val); G[(size_t)m * 8 + lane] = val; }
        }
    }
}

#define ATT_LOADK(kf, kb_) do { const int kb__ = (kb_); \
        if (kb__ < nkb_cache) { \
            const float* kp = ck + ((size_t)(cb * 512 + kb__ * 32 + r32) * 8 + h) * 64 + hi * 8; \
            _Pragma("unroll") for (int ds = 0; ds < 4; ++ds) { const f32x4 a = *(const f32x4*)(kp + ds * 16), b = *(const f32x4*)(kp + ds * 16 + 4); \
                u32x4 p; p.x = pk2(a.x, a.y); p.y = pk2(a.z, a.w); p.z = pk2(b.x, b.y); p.w = pk2(b.z, b.w); kf[ds] = __builtin_bit_cast(bf16x8, p); } \
        } else { \
            const int kr = krow0 + (kb__ - nkb_cache) * 32; \
            _Pragma("unroll") for (int ds = 0; ds < 4; ++ds) kf[ds] = *(const bf16x8*)(KF + ((((size_t)(kr >> 5) * 8 + h) * 4 + ds) * 64 + lane) * 8); \
        } } while (0)
#define ATT_LOADV(vf, kb_) do { const int kb__ = (kb_); \
        if (kb__ < nkb_cache) { \
            _Pragma("unroll") for (int db = 0; db < 2; ++db) _Pragma("unroll") for (int ks = 0; ks < 2; ++ks) { float t8[8]; \
                _Pragma("unroll") for (int j = 0; j < 8; ++j) { const int key = kb__ * 32 + 16 * ks + 8 * (j >> 2) + 4 * hi + (j & 3); t8[j] = cv[((size_t)(cb * 512 + key) * 8 + h) * 64 + db * 32 + r32]; } \
                vf[db][ks] = pack8f(t8); } \
        } else { \
            const int kr = krow0 + (kb__ - nkb_cache) * 32; \
            _Pragma("unroll") for (int db = 0; db < 2; ++db) _Pragma("unroll") for (int ks = 0; ks < 2; ++ks) vf[db][ks] = *(const bf16x8*)(VT + ((((((size_t)(kr >> 5) * 8 + h) * 2 + db) * 2 + ks) * 64 + lane) * 8)); \
        } } while (0)
__device__ __forceinline__ float xh_max(float v) { auto rr = __builtin_amdgcn_permlane32_swap(__float_as_uint(v), __float_as_uint(v), false, false); return fmaxf(__uint_as_float(rr[0]), __uint_as_float(rr[1])); }
__device__ __forceinline__ float xh_sum(float v) { auto rr = __builtin_amdgcn_permlane32_swap(__float_as_uint(v), __float_as_uint(v), false, false); return __uint_as_float(rr[0]) + __uint_as_float(rr[1]); }
#define ATT_QK(st, kf) do { _Pragma("unroll") for (int qb = 0; qb < NQB; ++qb) { \
            _Pragma("unroll") for (int r = 0; r < 16; ++r) st[qb][r] = 0.f; \
            _Pragma("unroll") for (int ds = 0; ds < 4; ++ds) st[qb] = MFMA32(kf[ds], qf[qb][ds], st[qb]); } } while (0)
#define ATT_SM_PV(st, vf, kb_) do { const int kposb = kpos0 + (kb_) * 32; \
        _Pragma("unroll") for (int qb = 0; qb < NQB; ++qb) { \
            const int qposb = qpos0 + qb * 32; \
            float bm = -1e30f; \
            if (qposb - kposb - 31 >= 128) { const float bias = rb[256]; \
                _Pragma("unroll") for (int r = 0; r < 16; ++r) { st[qb][r] = st[qb][r] * C2 + bias; bm = fmaxf(bm, st[qb][r]); } \
            } else { const int dq = qposb + r32 - kposb; \
                _Pragma("unroll") for (int r = 0; r < 16; ++r) { int d = dq - crow(r, hi); d = d < -128 ? -128 : (d > 128 ? 128 : d); st[qb][r] = st[qb][r] * C2 + rb[d + 128]; bm = fmaxf(bm, st[qb][r]); } \
            } \
            bm = xh_max(bm); \
            const float mnew = fmaxf(mrun[qb], bm), f = __builtin_amdgcn_exp2f(mrun[qb] - mnew); \
            float ps = 0.f; float p[16]; \
            _Pragma("unroll") for (int r = 0; r < 16; ++r) { p[r] = __builtin_amdgcn_exp2f(st[qb][r] - mnew); ps += p[r]; } \
            lrun[qb] = lrun[qb] * f + ps; mrun[qb] = mnew; \
            _Pragma("unroll") for (int db = 0; db < 2; ++db) _Pragma("unroll") for (int r = 0; r < 16; ++r) O[qb][db][r] *= f; \
            const bf16x8 p0 = pack8f(p), p1 = pack8f(p + 8); \
            _Pragma("unroll") for (int db = 0; db < 2; ++db) { O[qb][db] = MFMA32(vf[db][0], p0, O[qb][db]); O[qb][db] = MFMA32(vf[db][1], p1, O[qb][db]); } \
        } } while (0)
template <int NQB>
__device__ __forceinline__ void attn_unit(const bf16* Z, const bf16* KF, const bf16* VT, const float* ck, const float* cv, bf16* MIX, const LAS float* rb,
                                          int h, int qrow0, int krow0, int nkb_cache, int nkb_new, int cb, int qpos0, int kpos0, int lane) {
    const int r32 = lane & 31, hi = lane >> 5; constexpr float C2 = 0.125f * 1.4426950408889634f;
    bf16x8 qf[NQB][4];
#pragma unroll
    for (int qb = 0; qb < NQB; ++qb)
#pragma unroll
        for (int ds = 0; ds < 4; ++ds) qf[qb][ds] = *(const bf16x8*)(Z + (size_t)(qrow0 + qb * 32 + r32) * NZ + h * 64 + ds * 16 + hi * 8);
    float mrun[NQB], lrun[NQB]; f32x16 O[NQB][2];
#pragma unroll
    for (int qb = 0; qb < NQB; ++qb) { mrun[qb] = -1e30f; lrun[qb] = 0.f;
#pragma unroll
        for (int db = 0; db < 2; ++db)
#pragma unroll
            for (int r = 0; r < 16; ++r) O[qb][db][r] = 0.f; }
    const int nkb = nkb_cache + nkb_new;
    bf16x8 kfA[4], kfB[4], vf[2][2]; f32x16 st[NQB];
    if constexpr (NQB == 1) {
        bf16x8 vfB[2][2];
        ATT_LOADK(kfA, 0); ATT_LOADV(vf, 0);
        for (int kb = 0; kb < nkb; kb += 2) {
            if (kb + 1 < nkb) { ATT_LOADK(kfB, kb + 1); ATT_LOADV(vfB, kb + 1); }
            ATT_QK(st, kfA); ATT_SM_PV(st, vf, kb);
            if (kb + 1 < nkb) {
                if (kb + 2 < nkb) { ATT_LOADK(kfA, kb + 2); ATT_LOADV(vf, kb + 2); }
                ATT_QK(st, kfB); ATT_SM_PV(st, vfB, kb + 1); }
        }
    } else {
    ATT_LOADK(kfA, 0);
    for (int kb = 0; kb < nkb; kb += 2) {
        ATT_LOADV(vf, kb);
        if (kb + 1 < nkb) ATT_LOADK(kfB, kb + 1);
        ATT_QK(st, kfA); ATT_SM_PV(st, vf, kb);
        if (kb + 1 < nkb) { ATT_LOADV(vf, kb + 1);
            if (kb + 2 < nkb) ATT_LOADK(kfA, kb + 2);
            ATT_QK(st, kfB); ATT_SM_PV(st, vf, kb + 1); }
    }
    }
#pragma unroll
    for (int qb = 0; qb < NQB; ++qb) {
        const float lt = xh_sum(lrun[qb]); const float inv = 1.0f / lt;
        bf16* op = MIX + (size_t)(qrow0 + qb * 32 + r32) * DM + h * 64 + 4 * hi;
#pragma unroll
        for (int db = 0; db < 2; ++db)
#pragma unroll
            for (int a = 0; a < 4; ++a) { u32x2 w; w.x = pk2(O[qb][db][4 * a] * inv, O[qb][db][4 * a + 1] * inv); w.y = pk2(O[qb][db][4 * a + 2] * inv, O[qb][db][4 * a + 3] * inv);
                *(u32x2*)(op + db * 32 + 8 * a) = w; }
    }
}
#undef ATT_LOADK
#undef ATT_LOADV
#undef ATT_QK
#undef ATT_SM_PV

constexpr int VT_LD = 72;
__device__ __forceinline__ int tix(int row, int col) { return row * VT_LD + ((((col >> 3) ^ (row >> 3)) & 7) << 3) + (col & 7); }
constexpr int ML_WK = 16384, ML_VT = ML_WK + 128 * VT_LD * 2, ML_F = ML_VT + 128 * VT_LD * 2;
__device__ __forceinline__ void unit_gates(const float* G, int row0, int L, int h, int lane, float& b, float& g, float& bL, float& Gmax) {
    const bool valid = lane < L;
    const float ig = valid ? G[(size_t)(row0 + lane) * 8 + h] : 0.f, lf = valid ? G[(size_t)(row0 + lane) * 8 + 4 + h] : 0.f;
    b = lf;
#pragma unroll
    for (int o = 1; o < 64; o <<= 1) { const float x = __shfl_up(b, o); if (lane >= o) b += x; }
    g = valid ? ig - b : -1e30f;
    Gmax = wave_max(g);
    bL = __shfl(b, L - 1);
}
__device__ __forceinline__ void unit_decode(int u, int& row0, int& L, int& h, int& c, int& sb) {
    if (u < NU_P) { const int b = u >> 10; c = (u >> 2) & 255; h = u & 3; row0 = b * 16384 + c * 64; L = 64; sb = -1; }
    else { const int v = u - NU_P; sb = v >> 2; h = v & 3; c = 0; row0 = TP + sb * 32; L = 32; }
}
constexpr int ML_GATE = 57344;
__device__ __forceinline__ void mlstm_m1_phase(const Ptrs& P, LAS unsigned char* lds, int tid, int wave, int lane, int G_) {
    unsigned char* ws = P.ws;
    const bf16* Z = (const bf16*)(ws + WS_BIG); const float* G = (const float*)(ws + WS_G);
    bf16* QC = (bf16*)(ws + WS_QC); bf16* KC = (bf16*)(ws + WS_KC); bf16* DC = (bf16*)(ws + WS_DC); float* DN = (float*)(ws + WS_DN); float* SC = (float*)(ws + WS_SC);
    LAS bf16* wkT = (LAS bf16*)(lds + ML_WK); LAS bf16* vT = (LAS bf16*)(lds + ML_VT); LAS float* gt = (LAS float*)(lds + ML_GATE);
    const int nun = (NU - (int)blockIdx.x + G_ - 1) / G_;
    for (int k = wave; k < nun; k += NWAVES) { const int u = blockIdx.x + k * G_; int row0, L, h, c, sb; unit_decode(u, row0, L, h, c, sb);
        float b, g, bL, Gm; unit_gates(G, row0, L, h, lane, b, g, bL, Gm); LAS float* sWk = gt + (k & 15) * 68; sWk[lane] = (lane < L) ? __expf(g - Gm) : 0.f;
        if (lane == 0) { SC[2 * u] = bL; SC[2 * u + 1] = Gm;
            if (sb >= 0) { const int chn = u - NU_P; const float m = P.in[6][chn], Mx = fmaxf(m, Gm); sWk[64] = __expf(m - Mx); sWk[65] = __expf(Gm - Mx); P.out[O_MS + chn] = bL + Mx; } } }
    const int cg = tid & 31; const bool isk = cg >= 16; const int s0 = tid >> 5; const int vg = tid & 15; const int sv0 = tid >> 4;
    u32x4 zr[4][4], vr[2];
#define M1_LOAD(uu) do { int row0_, L_, h_, c_, sb_; unit_decode((uu), row0_, L_, h_, c_, sb_); const int ch_ = (isk ? 512 : 0) + h_ * 128 + 8 * (cg & 15); const int nit_ = L_ >> 4; \
        _Pragma("unroll") for (int i = 0; i < 4; ++i) if (i < nit_) _Pragma("unroll") for (int j = 0; j < 4; ++j) { const int p = s0 + 16 * i - 3 + j; \
            if (p >= 0 || c_ > 0) zr[i][j] = *(const u32x4*)(Z + (size_t)(row0_ + p) * NZ + 1024 + ch_); \
            else if (sb_ >= 0) { const float* sp = P.in[7] + ((size_t)sb_ * 3 + (3 + p)) * 1024 + ch_; const f32x4 a = *(const f32x4*)sp, b2 = *(const f32x4*)(sp + 4); \
                zr[i][j].x = pk2(a.x, a.y); zr[i][j].y = pk2(a.z, a.w); zr[i][j].z = pk2(b2.x, b2.y); zr[i][j].w = pk2(b2.z, b2.w); } \
            else zr[i][j] = (u32x4){0u, 0u, 0u, 0u}; } \
        _Pragma("unroll") for (int i = 0; i < 2; ++i) if (sv0 + 32 * i < L_) vr[i] = *(const u32x4*)(Z + (size_t)(row0_ + sv0 + 32 * i) * NZ + 2048 + h_ * 128 + 8 * vg); } while (0)
    if (nun > 0) M1_LOAD((int)blockIdx.x);
    __syncthreads();
    for (int k = 0; k < nun; ++k) { const int u = blockIdx.x + k * G_; int row0, L, h, c, sb; unit_decode(u, row0, L, h, c, sb);
        const int ch = (isk ? 512 : 0) + h * 128 + 8 * (cg & 15); const int nit = L >> 4; const LAS float* sWk = gt + (k & 15) * 68;
        f32x4 w[4][2], bb[2];
        { const float* cw = P.in[14]; const float* cbias = P.in[15];
#pragma unroll
          for (int j = 0; j < 4; ++j) { w[j][0] = *(const f32x4*)(cw + j * 1024 + ch); w[j][1] = *(const f32x4*)(cw + j * 1024 + ch + 4); }
          bb[0] = *(const f32x4*)(cbias + ch); bb[1] = *(const f32x4*)(cbias + ch + 4); }
#pragma unroll
        for (int i = 0; i < 2; ++i) if (sv0 + 32 * i < L) { const u32x4 r = vr[i]; LAS bf16* d = vT + tix(8 * vg, sv0 + 32 * i);
            d[0] = (bf16)(r.x & 0xffff); d[VT_LD] = (bf16)(r.x >> 16); d[2 * VT_LD] = (bf16)(r.y & 0xffff); d[3 * VT_LD] = (bf16)(r.y >> 16);
            d[4 * VT_LD] = (bf16)(r.z & 0xffff); d[5 * VT_LD] = (bf16)(r.z >> 16); d[6 * VT_LD] = (bf16)(r.w & 0xffff); d[7 * VT_LD] = (bf16)(r.w >> 16); }
#pragma unroll
        for (int i = 0; i < 4; ++i) if (i < nit) { const int s_ = s0 + 16 * i;
            float y[8];
#pragma unroll
            for (int e = 0; e < 4; ++e) { y[e] = bb[0][e]; y[4 + e] = bb[1][e]; }
#pragma unroll
            for (int j = 0; j < 4; ++j) { const u32x4 r = zr[i][j]; float x[8];
                x[0] = bflo(r.x); x[1] = bfhi(r.x); x[2] = bflo(r.y); x[3] = bfhi(r.y); x[4] = bflo(r.z); x[5] = bfhi(r.z); x[6] = bflo(r.w); x[7] = bfhi(r.w);
#pragma unroll
                for (int e = 0; e < 4; ++e) { y[e] += x[e] * w[j][0][e]; y[4 + e] += x[4 + e] * w[j][1][e]; } }
            const float sc = isk ? 0.08838834764831845f : 1.0f;
#pragma unroll
            for (int e = 0; e < 8; ++e) y[e] = silu(y[e]) * sc;
            u32x4 o; o.x = pk2(y[0], y[1]); o.y = pk2(y[2], y[3]); o.z = pk2(y[4], y[5]); o.w = pk2(y[6], y[7]);
            { const int d0 = 8 * (cg & 15), rw = row0 + s_; *(u32x4*)((isk ? KC : QC) + (((size_t)((rw >> 5) * 4 + h) * 8 + (d0 >> 4)) * 64 + ((d0 >> 3) & 1) * 32 + (rw & 31)) * 8) = o; }
            if (isk) { const float wk = sWk[s_];
#pragma unroll
                for (int e = 0; e < 8; ++e) wkT[tix(8 * (cg & 15) + e, s_)] = f2bf(y[e] * wk); }
        }
        __syncthreads();
        if (k + 1 < nun) M1_LOAD(u + G_);
        {
            const int r32 = lane & 31, hi = lane >> 5, eb = wave & 3, dp = wave >> 2; const int nks = L >> 4;
#pragma unroll
            for (int dbi = 0; dbi < 2; ++dbi) { const int db = dp * 2 + dbi; f32x16 acc;
#pragma unroll
                for (int r = 0; r < 16; ++r) acc[r] = 0.f;
#pragma unroll
                for (int ks = 0; ks < 4; ++ks) if (ks < nks) { const bf16x8 A = *(const LAS bf16x8*)(wkT + tix(db * 32 + r32, ks * 16 + hi * 8)), B = *(const LAS bf16x8*)(vT + tix(eb * 32 + r32, ks * 16 + hi * 8));
                    acc = MFMA32(A, B, acc); }
                if (sb < 0) {
#pragma unroll
                    for (int a = 0; a < 4; ++a) { u32x2 wv; wv.x = pk2(acc[4 * a], acc[4 * a + 1]); wv.y = pk2(acc[4 * a + 2], acc[4 * a + 3]);
                        *(u32x2*)(DC + ((((size_t)u * 4 + eb) * 8 + 2 * db + (a >> 1)) * 64 + (a & 1) * 32 + r32) * 8 + 4 * hi) = wv; } }
                else { const int chn = u - NU_P; const float dec = sWk[64], gn = sWk[65];
#pragma unroll
                    for (int r = 0; r < 16; ++r) { const size_t ci = (size_t)chn * 16384 + (db * 32 + crow(r, hi)) * 128 + eb * 32 + r32; P.out[O_CS + ci] = dec * P.in[4][ci] + gn * acc[r]; } } }
            if (tid < 128) { float sm = 0.f;
#pragma unroll
                for (int q = 0; q < 8; ++q) if (q * 8 < L) { const u32x4 r = *(const LAS u32x4*)(wkT + tix(tid, q * 8)); sm += (bflo(r.x) + bfhi(r.x)) + (bflo(r.y) + bfhi(r.y)) + (bflo(r.z) + bfhi(r.z)) + (bflo(r.w) + bfhi(r.w)); }
                if (sb < 0) DN[(size_t)u * 128 + tid] = sm; else { const int chn = u - NU_P; P.out[O_NS + chn * 128 + tid] = sWk[64] * P.in[5][chn * 128 + tid] + sWk[65] * sm; } }
        }
        __syncthreads();
    }
#undef M1_LOAD
}
__device__ __forceinline__ void mlstm_m2(const Ptrs& P, LAS unsigned char* lds, int tid, int wave, int lane, int G_) {
    unsigned char* ws = P.ws; float* out = P.out;
    bf16* DC = (bf16*)(ws + WS_DC); float* DN = (float*)(ws + WS_DN); const float* SC = (const float*)(ws + WS_SC); float* SM = (float*)(ws + WS_SC + 65536);
    LAS float* sDec = (LAS float*)lds;
    LAS float* sGn = (LAS float*)(lds + 8192);
    LAS float* sM = (LAS float*)(lds + 16384);
    {
        const int b = wave >> 2, h = wave & 3; float bL[4], Gm[4];
#pragma unroll
        for (int k = 0; k < 4; ++k) { const int u = b * 1024 + (4 * lane + k) * 4 + h; bL[k] = SC[2 * u]; Gm[k] = SC[2 * u + 1]; }
        float A = bL[0], D = Gm[0] + bL[0];
#pragma unroll
        for (int k = 1; k < 4; ++k) { D = fmaxf(D + bL[k], Gm[k] + bL[k]); A += bL[k]; }
#pragma unroll
        for (int o = 1; o < 64; o <<= 1) { const float Ap = __shfl_up(A, o), Dp = __shfl_up(D, o); if (lane >= o) { D = fmaxf(Dp + A, D); A = Ap + A; } }
        const float Ae = __shfl_up(A, 1), De = __shfl_up(D, 1);
        float m = lane ? fmaxf(Ae, De) : 0.f;
#pragma unroll
        for (int k = 0; k < 4; ++k) { const int c = 4 * lane + k; const float Mx = fmaxf(m, Gm[k]); sM[wave * 257 + c] = m; sDec[wave * 256 + c] = __expf(m - Mx); sGn[wave * 256 + c] = __expf(Gm[k] - Mx); m = bL[k] + Mx; }
        if (lane == 63) sM[wave * 257 + 256] = m;
    }
    __syncthreads();
    if (wave < 2) {
        for (int hv = ((int)blockIdx.x * 2 + wave) * 64 + lane; hv < 32768; hv += G_ * 128) { const int ch = hv >> 12, off = (hv & 4095) * 4, b = ch >> 2, h = ch & 3;
            bf16* p = DC + (size_t)(b * 1024 + h) * 16384 + off; float carry[4];
#pragma unroll
            for (int j = 0; j < 4; ++j) carry[j] = 0.f;
            for (int c = 0; c < 256; c += 32) { u32x2 x[32];
#pragma unroll
                for (int k = 0; k < 32; ++k) x[k] = *(const u32x2*)(p + (size_t)(c + k) * 65536);
#pragma unroll
                for (int k = 0; k < 32; ++k) { const float dec = sDec[ch * 256 + c + k], gn = sGn[ch * 256 + c + k];
                    u32x2 o; o.x = pk2(carry[0], carry[1]); o.y = pk2(carry[2], carry[3]);
                    *(u32x2*)(p + (size_t)(c + k) * 65536) = o;
                    carry[0] = dec * carry[0] + gn * bflo(x[k].x); carry[1] = dec * carry[1] + gn * bfhi(x[k].x); carry[2] = dec * carry[2] + gn * bflo(x[k].y); carry[3] = dec * carry[3] + gn * bfhi(x[k].y); } }
            const int pi = off >> 3, ee = (pi >> 9) * 32 + (pi & 31), dd = ((pi >> 6) & 7) * 16 + ((pi >> 5) & 1) * 8 + ((off >> 2) & 1) * 4;
#pragma unroll
            for (int j = 0; j < 4; ++j) out[O_CP + (size_t)ch * 16384 + (dd + j) * 128 + ee] = carry[j]; }
    } else if (wave == 3) {
        for (int i = blockIdx.x * 64 + lane; i < 1024; i += G_ * 64) { const int ch = i >> 7, d = i & 127, b = ch >> 2, h = ch & 3; float carry = 0.f;
            float* pn = DN + (size_t)(b * 1024 + h) * 128 + d;
            for (int c = 0; c < 256; c += 16) { float x[16];
#pragma unroll
                for (int k = 0; k < 16; ++k) x[k] = pn[(size_t)(c + k) * 512];
#pragma unroll
                for (int k = 0; k < 16; ++k) { pn[(size_t)(c + k) * 512] = carry; carry = sDec[ch * 256 + c + k] * carry + sGn[ch * 256 + c + k] * x[k]; } }
            out[O_NP + ch * 128 + d] = carry; }
    } else if (blockIdx.x == 0 && wave >= 4) {
        for (int i = tid - 256; i < NU_P; i += NTHR - 256) { const int b = i >> 10, c = (i >> 2) & 255, h = i & 3; SM[i] = sM[(b * 4 + h) * 257 + c]; }
        if (tid >= 256 && tid < 264) out[O_MP + tid - 256] = sM[(tid - 256) * 257 + 256];
    }
}
__device__ __forceinline__ void mlstm_m3_gates(const Ptrs& P, LAS unsigned char* lds, int wave, int lane, int G_) {
    unsigned char* ws = P.ws; const float* G = (const float*)(ws + WS_G); const float* DN = (const float*)(ws + WS_DN); const float* SM = (const float*)(ws + WS_SC + 65536);
    const int nun = (NU - (int)blockIdx.x + G_ - 1) / G_;
    for (int k = wave; k < nun; k += NWAVES) { const int u = blockIdx.x + k * G_; int row0, L, h, c, sb; unit_decode(u, row0, L, h, c, sb);
        LAS float* gtab = (LAS float*)(lds + ML_GATE) + (k & 15) * 384;
        const float* np_ = (sb < 0) ? DN + (size_t)u * 128 : P.in[5] + (size_t)(u - NU_P) * 128; const float n0 = np_[lane], n1 = np_[64 + lane];
        float b, g, bL, Gm; unit_gates(G, row0, L, h, lane, b, g, bL, Gm); const float mc = (sb < 0) ? SM[u] : P.in[6][u - NU_P];
        float Mx = g;
#pragma unroll
        for (int o = 1; o < 64; o <<= 1) { const float x = __shfl_up(Mx, o); if (lane >= o) Mx = fmaxf(Mx, x); }
        const float Mt = fmaxf(mc, Mx);
        gtab[lane] = g; gtab[64 + lane] = Mt; gtab[128 + lane] = __expf(mc - Mt); gtab[192 + lane] = __expf(-(b + Mt)); gtab[256 + lane] = n0; gtab[320 + lane] = n1; }
}
__device__ __forceinline__ void mlstm_m3_unit(const Ptrs& P, LAS unsigned char* lds, int u, int kslot, int tid, int wave, int lane) {
    unsigned char* ws = P.ws;
    const bf16* Z = (const bf16*)(ws + WS_BIG); const float* G = (const float*)(ws + WS_G);
    const bf16* QC = (const bf16*)(ws + WS_QC); const bf16* KC = (const bf16*)(ws + WS_KC); const bf16* DC = (const bf16*)(ws + WS_DC); const float* DN = (const float*)(ws + WS_DN);
    const float* SM = (const float*)(ws + WS_SC + 65536); bf16* MIX = (bf16*)(ws + WS_H);
    LAS bf16* vT = (LAS bf16*)(lds + ML_VT); LAS float* F = (LAS float*)(lds + ML_F);
    const LAS float* gtab = (const LAS float*)(lds + ML_GATE) + (kslot & 15) * 384;
    const LAS float* sg = gtab, *sMt = gtab + 64, *siw = gtab + 128, *semt = gtab + 192, *sN = gtab + 256; LAS float* sSS = F + 384;
    int row0, L, h, c, sb; unit_decode(u, row0, L, h, c, sb);
    const int r32 = lane & 31, hi = lane >> 5, eb = wave & 3, tb = wave >> 2; const bool active = tb * 32 < L; const int t = tb * 32 + r32;
    const int vg = tid & 15; const int sv0 = tid >> 4; u32x4 vr[2];
#pragma unroll
    for (int i = 0; i < 2; ++i) if (sv0 + 32 * i < L) vr[i] = *(const u32x4*)(Z + (size_t)(row0 + sv0 + 32 * i) * NZ + 2048 + h * 128 + 8 * vg);
    bf16x8 qf[8], Kf[2][8], Cf[8]; u32x2 og[4]; f32x4 gnm[4];
    if (active) {
#pragma unroll
        for (int ds = 0; ds < 8; ++ds) qf[ds] = *(const bf16x8*)(QC + (((size_t)(((row0 >> 5) + tb) * 4 + h) * 8 + ds) * 64 + lane) * 8);
#pragma unroll
        for (int ds = 0; ds < 8; ++ds) {
            if (sb < 0) Cf[ds] = *(const bf16x8*)(DC + ((((size_t)u * 4 + eb) * 8 + ds) * 64 + lane) * 8);
            else { const float* cp = P.in[4] + (size_t)(u - NU_P) * 16384 + (size_t)(ds * 16 + hi * 8) * 128 + eb * 32 + r32; float t8[8];
#pragma unroll
                for (int j = 0; j < 8; ++j) t8[j] = cp[j * 128];
                Cf[ds] = pack8f(t8); } }
#pragma unroll
        for (int sbk = 0; sbk < 2; ++sbk) if (sbk <= tb)
#pragma unroll
            for (int ds = 0; ds < 8; ++ds) Kf[sbk][ds] = *(const bf16x8*)(KC + (((size_t)(((row0 >> 5) + sbk) * 4 + h) * 8 + ds) * 64 + lane) * 8);
#pragma unroll
        for (int a = 0; a < 4; ++a) { og[a] = *(const u32x2*)(Z + (size_t)(row0 + t) * NZ + 2560 + h * 128 + eb * 32 + 8 * a + 4 * hi); gnm[a] = *(const f32x4*)(P.in[18] + h * 128 + eb * 32 + 4 * hi + 8 * a); }
    }
#pragma unroll
    for (int i = 0; i < 2; ++i) if (sv0 + 32 * i < L) { const u32x4 r = vr[i]; LAS bf16* d = vT + tix(8 * vg, sv0 + 32 * i);
        d[0] = (bf16)(r.x & 0xffff); d[VT_LD] = (bf16)(r.x >> 16); d[2 * VT_LD] = (bf16)(r.y & 0xffff); d[3 * VT_LD] = (bf16)(r.y >> 16);
        d[4 * VT_LD] = (bf16)(r.z & 0xffff); d[5 * VT_LD] = (bf16)(r.z >> 16); d[6 * VT_LD] = (bf16)(r.w & 0xffff); d[7 * VT_LD] = (bf16)(r.w >> 16); }
    __syncthreads();
    float val[16];
    if (active) {
        f32x16 acc;
#pragma unroll
        for (int r = 0; r < 16; ++r) acc[r] = 0.f;
#pragma unroll
        for (int ds = 0; ds < 8; ++ds) acc = MFMA32(Cf[ds], qf[ds], acc);
        const float iw = siw[t], Mt = sMt[t];
#pragma unroll
        for (int r = 0; r < 16; ++r) acc[r] *= iw;
        float qn = 0.f;
#pragma unroll
        for (int ds = 0; ds < 8; ++ds)
#pragma unroll
            for (int j = 0; j < 8; ++j) qn += bf2f((bf16)qf[ds][j]) * sN[ds * 16 + hi * 8 + j];
        qn = xh_sum(qn);
        float den = iw * qn;
#pragma unroll
        for (int sbk = 0; sbk < 2; ++sbk) if (sbk <= tb) {
            f32x16 st;
#pragma unroll
            for (int r = 0; r < 16; ++r) st[r] = 0.f;
#pragma unroll
            for (int ds = 0; ds < 8; ++ds) st = MFMA32(Kf[sbk][ds], qf[ds], st);
            float p[16]; float ps = 0.f;
#pragma unroll
            for (int r = 0; r < 16; ++r) { const int s_ = sbk * 32 + crow(r, hi); const float w = __expf(fminf(sg[s_] - Mt, 0.f)); p[r] = (s_ <= t) ? st[r] * w : 0.f; ps += p[r]; }
            ps = xh_sum(ps); den += ps;
            const bf16x8 p0 = pack8f(p), p1 = pack8f(p + 8);
            const int vrow = eb * 32 + r32;
            { const u32x2 lo = *(const LAS u32x2*)(vT + tix(vrow, sbk * 32 + 4 * hi)), hh = *(const LAS u32x2*)(vT + tix(vrow, sbk * 32 + 8 + 4 * hi)); u32x4 a; a.x = lo.x; a.y = lo.y; a.z = hh.x; a.w = hh.y; acc = MFMA32(__builtin_bit_cast(bf16x8, a), p0, acc); }
            { const u32x2 lo = *(const LAS u32x2*)(vT + tix(vrow, sbk * 32 + 16 + 4 * hi)), hh = *(const LAS u32x2*)(vT + tix(vrow, sbk * 32 + 24 + 4 * hi)); u32x4 a; a.x = lo.x; a.y = lo.y; a.z = hh.x; a.w = hh.y; acc = MFMA32(__builtin_bit_cast(bf16x8, a), p1, acc); }
        }
        const float inv = 1.0f / fmaxf(fabsf(den), semt[t]);
        float ss = 0.f;
#pragma unroll
        for (int a = 0; a < 4; ++a) {
            val[4 * a] = acc[4 * a] * inv * bflo(og[a].x); val[4 * a + 1] = acc[4 * a + 1] * inv * bfhi(og[a].x); val[4 * a + 2] = acc[4 * a + 2] * inv * bflo(og[a].y); val[4 * a + 3] = acc[4 * a + 3] * inv * bfhi(og[a].y);
            ss += (val[4 * a] * val[4 * a] + val[4 * a + 1] * val[4 * a + 1]) + (val[4 * a + 2] * val[4 * a + 2] + val[4 * a + 3] * val[4 * a + 3]); }
        ss = xh_sum(ss);
        if (hi == 0) sSS[eb * 64 + t] = ss;
    }
    __syncthreads();
    if (active) {
        const float tot = (sSS[t] + sSS[64 + t]) + (sSS[128 + t] + sSS[192 + t]); const float rstd = 1.0f / sqrtf(tot * (1.0f / 128.0f) + 1e-6f);
        bf16* op = MIX + (size_t)(row0 + t) * DM + 512 + h * 128 + eb * 32 + 4 * hi;
#pragma unroll
        for (int a = 0; a < 4; ++a) { const f32x4 gn = gnm[a]; u32x2 w; w.x = pk2(val[4 * a] * rstd * gn.x, val[4 * a + 1] * rstd * gn.y); w.y = pk2(val[4 * a + 2] * rstd * gn.z, val[4 * a + 3] * rstd * gn.w);
            *(u32x2*)(op + 8 * a) = w; }
    }
}

#define XB_TMO      128
#define XB_XCNT(j)  (256  + 64 * (j))
#define XB_XSUB(j)  (1280 + 64 * (j))
#define XB_XGEN(j)  (2304 + 64 * (j))
#define XB_TOP      3328
#define XB_TOPGEN   3392
#define XCD_BAR_WORDS 3456
#define XB_SPIN_CAP (1u << 18)

__device__ __forceinline__ unsigned xb_ld(unsigned* p)              { return __hip_atomic_load(p, __ATOMIC_RELAXED, __HIP_MEMORY_SCOPE_AGENT); }
__device__ __forceinline__ unsigned xb_add(unsigned* p, unsigned v) { return __hip_atomic_fetch_add(p, v, __ATOMIC_RELAXED, __HIP_MEMORY_SCOPE_AGENT); }
__device__ __forceinline__ unsigned xb_xcc_id() { return (unsigned)__builtin_amdgcn_s_getreg((3 << 11) | 20) & 0xFu; }
#define XB_SPIN(cond, bar) do { unsigned _sp = 0; while (cond) { __builtin_amdgcn_s_sleep(1); \
    if ((++_sp & 255u) == 0u) { if (xb_ld(&(bar)[XB_TMO])) break; if (_sp > XB_SPIN_CAP) { atomicAdd(&(bar)[XB_TMO], 1u); break; } } } } while (0)

struct XcdBarrier {
    unsigned* bar; unsigned x;
    volatile LAS unsigned* st;
};

__device__ __forceinline__ XcdBarrier xcd_barrier_post(unsigned* bar, volatile LAS unsigned* st) {
    XcdBarrier b; b.bar = bar; b.x = xb_xcc_id(); b.st = st;
    if (threadIdx.x == 0) (void)xb_add(&bar[XB_XCNT(b.x)], 1u);
    return b;
}
__device__ __forceinline__ void xcd_barrier_complete(unsigned* bar, unsigned x, unsigned& nloc, unsigned& nx) {
    const unsigned G = gridDim.x * gridDim.y * gridDim.z;
    unsigned sum, cnt, mine, sp = 0u;
    for (;;) {
        sum = 0u; cnt = 0u; mine = 0u;
#pragma unroll
        for (unsigned j = 0; j < 16; ++j) { const unsigned c = xb_ld(&bar[XB_XCNT(j)]); sum += c; cnt += (c > 0u) ? 1u : 0u; mine = (j == x) ? c : mine; }
        if (sum == G) break;
        __builtin_amdgcn_s_sleep(1);
        if ((++sp & 255u) == 0u) { if (xb_ld(&bar[XB_TMO])) break; if (sp > XB_SPIN_CAP) { atomicAdd(&bar[XB_TMO], 1u); break; } }
    }
    nloc = mine > 0u ? mine : 1u; nx = cnt > 0u ? cnt : 1u;
}

__device__ __forceinline__ void xcd_barrier(const XcdBarrier& b) {
    asm volatile("s_waitcnt vmcnt(0)" ::: "memory");
    __syncthreads();
    if (threadIdx.x == 0) {
        unsigned* bar = b.bar;
        __builtin_amdgcn_s_waitcnt(0);
        unsigned nloc = b.st[0], nx = b.st[1];
        if (nloc == 0u) { xcd_barrier_complete(bar, b.x, nloc, nx); b.st[0] = nloc; b.st[1] = nx; }
        const unsigned old = xb_add(&bar[XB_XSUB(b.x)], 1u);
        const unsigned gen = old / nloc;
        if (old + 1u == (gen + 1u) * nloc) {
            __builtin_amdgcn_fence(__ATOMIC_RELEASE, "agent");
            asm volatile("s_waitcnt vmcnt(0)" ::: "memory");
            const unsigned og = xb_add(&bar[XB_TOP], 1u);
            const unsigned tg = og / nx;
            if (og + 1u == (tg + 1u) * nx) xb_add(&bar[XB_TOPGEN], 1u);
            else XB_SPIN(xb_ld(&bar[XB_TOPGEN]) == tg, bar);
            __builtin_amdgcn_fence(__ATOMIC_ACQUIRE, "agent");
            xb_add(&bar[XB_XGEN(b.x)], 1u);
            asm volatile("s_waitcnt vmcnt(0)" ::: "memory");
        } else {
            XB_SPIN(xb_ld(&bar[XB_XGEN(b.x)]) == gen, bar);
            __builtin_amdgcn_fence(__ATOMIC_ACQUIRE, "agent");
            asm volatile("s_waitcnt vmcnt(0)" ::: "memory");
        }
    }
    __syncthreads();
}

__global__ void __launch_bounds__(NTHR, 2) fwd_kernel(Ptrs P) {
    extern __shared__ __attribute__((aligned(16))) unsigned char lds_raw[];
    LAS unsigned char* lds = (LAS unsigned char*)lds_raw;
    const int tid = threadIdx.x, lane = tid & 63, wave = __builtin_amdgcn_readfirstlane(tid >> 6);
    const int G_ = gridDim.x, gw = blockIdx.x * NWAVES + wave, NGW = G_ * NWAVES;
    unsigned char* ws = P.ws; float* out = P.out;
    bf16* XS = (bf16*)(out + O_Y);
    float* XSAMP = (float*)(ws + WS_QC + 44 * MiB);
    bf16* H = (bf16*)(ws + WS_H); bf16* ACT = (bf16*)(ws + WS_BIG); bf16* Z = (bf16*)(ws + WS_BIG); bf16* VT = (bf16*)(ws + WS_VT); float* Gt = (float*)(ws + WS_G);
    const int lo = P.ph_lo, hi_ = P.ph_hi;
    volatile LAS unsigned* bst = (volatile LAS unsigned*)(lds + LDS_BYTES - 64);
    if (tid < 16) bst[tid] = 0u;
    __syncthreads();
    XcdBarrier bar; bar.bar = (unsigned*)(ws + WS_CTL) + 4096; bar.x = 0; bar.st = nullptr;
    if (P.coop) bar = xcd_barrier_post((unsigned*)(ws + WS_CTL) + 4096, bst);
#define IN(k) (lo <= (k) && (k) < hi_)
#define SEAM(k) do { if (IN(k) && IN((k) + 1)) { if (P.coop == 2) cg::this_grid().sync(); else xcd_barrier(bar); } } while (0)

    if (IN(0)) { p0_weights(P, (LAS float*)(lds + wave * 16384), gw, NGW, lane, 0, 10752 - 4224, 4224, 8448);
        for (int i = blockIdx.x * NTHR + tid; i < TS * DM / 4; i += G_ * NTHR) { const f32x4 xv = ((const f32x4*)P.in[1])[i]; u32x2 w; w.x = pk2(xv.x, xv.y); w.y = pk2(xv.z, xv.w); ((u32x2*)(XS + (size_t)TP * DM))[i] = w; } rms_rows<0>(P.in[0], P.in[1], P.in[8], H, nullptr, nullptr, nullptr, nullptr, gw, NGW, lane, nullptr, 0, nullptr); }
    SEAM(0);
    if (IN(1)) { pg8::Gemm g{H, (const bf16*)(ws + WS_W13A), T, 2 * FF, DM}; pg8::StaticOrder S; S.init(T, 2 * FF, G_, (int)blockIdx.x, DM); pg8::EpiSwiGLU E{ACT, FF};
        pg8::gemm_phase<pg8::EpiSwiGLU, pg8::StaticOrder, true, true>(lds, g, S, E); }
    SEAM(1);
    if (IN(2)) { pg8::Gemm g{ACT, (const bf16*)(ws + WS_W2A), T, DM, FF}; pg8::TailOrder S; S.init(TP, TS, DM, G_, (int)blockIdx.x, FF, 11); pg8::EpiResIn E{P.in[0], P.in[1], XS, (float*)(ws + WS_QC)};
        pg8::gemm_phase<pg8::EpiResIn, pg8::TailOrder, true, true, true>(lds, g, S, E); }
    SEAM(2);
    if (IN(3)) {
        LAS float* gwl = (LAS float*)lds; const float* win = P.in[13];
        for (int i = tid; i < 8192; i += NTHR) { const int k = i >> 3, q = i & 7; const int l = (k & 255) >> 2, ii = k & 3, j = k >> 8; gwl[((j * 4 + ii) * 64 + l) * 8 + q] = win[(size_t)k * 3592 + 3584 + q]; }
        __syncthreads();
        rms_rows_b<1>(XS, P.in[12], H, gwl, P.in[16], Gt, gw, NGW, lane, (const float*)(ws + WS_QC), 11, nullptr);
        __syncthreads();
    }
    SEAM(3);
    if (IN(4)) {
        { pg8::Gemm g{H, (const bf16*)(ws + WS_WIN), T, NZ, DM}; pg8::StaticOrder S; S.init(T, NZ, G_, (int)blockIdx.x, DM); pg8::EpiZ E{Z, out + O_KP, out + O_KS, (bf16*)(ws + WS_KF)};
          pg8::gemm_phase<pg8::EpiZ, pg8::StaticOrder, true, true>(lds, g, S, E); }
        { pg8::Gemm g{(const bf16*)(ws + WS_WV), H, 512, T, DM}; pg8::StaticOrder S; S.init(512, T, G_, (int)((blockIdx.x + G_ - 48) % G_), DM); pg8::EpiVT E{VT, out + O_VP, out + O_VS};
          pg8::gemm_phase<pg8::EpiVT, pg8::StaticOrder, true, true>(lds, g, S, E); }
    }
    SEAM(4);
    if (IN(5)) {
        LAS float* rb = (LAS float*)lds; const float* rbg = P.in[17];
        for (int i = tid; i < 8 * 257; i += NTHR) rb[i] = rbg[i] * 1.4426950408889634f;
        __syncthreads();
        if (G_ == 256) {
            const int vcu = ((int)blockIdx.x & 7) * 32 + ((int)blockIdx.x >> 3); const int h = wave;
            const int b = vcu >> 7;
            for (int cc = 0; cc < 2; ++cc) { const int c = (vcu & 127) * 2 + cc; const int c0 = c > 8 ? c - 8 : 0;
                attn_unit<2>(Z, (const bf16*)(ws + WS_KF), VT, nullptr, nullptr, H, rb + h * 257, h, b * 16384 + c * 64, b * 16384 + c0 * 64, 0, (c - c0 + 1) * 2, 0, c * 64, c0 * 64, lane); }
        } else
        for (int u = gw + 256; u < 256 + 4096; u += NGW) {
            { const int v = u - 256, h = v & 7, c = (v >> 3) & 255, b = v >> 11; const int c0 = c > 8 ? c - 8 : 0;
                attn_unit<2>(Z, (const bf16*)(ws + WS_KF), VT, nullptr, nullptr, H, rb + h * 257, h, b * 16384 + c * 64, b * 16384 + c0 * 64, 0, (c - c0 + 1) * 2, 0, c * 64, c0 * 64, lane); }
        }
        __syncthreads();
    }
    if (IN(6)) {
        mlstm_m1_phase(P, lds, tid, wave, lane, G_);
        for (int i = blockIdx.x * NTHR + tid; i < 34 * 3 * 1024; i += G_ * NTHR) { const int ch = i & 1023, j = (i >> 10) % 3, b = i / 3072;
            if (b < 2) out[O_CVP + (size_t)(b * 3 + j) * 1024 + ch] = bf2f(Z[(size_t)(b * 16384 + 16381 + j) * NZ + 1024 + ch]);
            else out[O_CVS + (size_t)((b - 2) * 3 + j) * 1024 + ch] = bf2f(Z[(size_t)(TP + (b - 2) * 32 + 29 + j) * NZ + 1024 + ch]); }
    }
    SEAM(6);
    if (IN(7)) {
        LAS float* rb = (LAS float*)(lds + 32768); const float* rbg = P.in[17];
        for (int i = tid; i < 8 * 257; i += NTHR) rb[i] = rbg[i] * 1.4426950408889634f;
        mlstm_m2(P, lds, tid, wave, lane, G_);
        if (wave >= 3) p0_weights(P, (LAS float*)(lds + 49152 + (wave - 3) * 8448), (int)blockIdx.x * 5 + (wave - 3), G_ * 5, lane, 4224, 8448, 1 << 30, 1 << 30);
        if (wave >= 2) for (int u = blockIdx.x + G_ * (wave - 2); u < 256; u += G_ * 6) { const int b = u >> 3, h = u & 7;
            attn_unit<1>(Z, (const bf16*)(ws + WS_KF), VT, P.in[2], P.in[3], H, rb + h * 257, h, TP + b * 32, TP + b * 32, 16, 1, b, 4096, 3584, lane); }
    }
    SEAM(7);
    if (IN(8)) { mlstm_m3_gates(P, lds, wave, lane, G_); __syncthreads(); int kslot = 0; for (int u = blockIdx.x; u < NU; u += G_, ++kslot) mlstm_m3_unit(P, lds, u, kslot, tid, wave, lane); }
    SEAM(8);
    if (IN(9)) { pg8::Gemm g{H, (const bf16*)(ws + WS_WOUT), T, DM, DM}; pg8::TailOrder S; S.init(TP, TS, DM, G_, (int)blockIdx.x, DM, 4); pg8::EpiResB<2> E{XS, XS, (float*)(ws + WS_QC)};
        pg8::gemm_phase<pg8::EpiResB<2>, pg8::TailOrder, true, true>(lds, g, S, E); }
    SEAM(9);
    if (IN(10)) rms_rows_b<0>(XS, P.in[20], H, nullptr, nullptr, nullptr, gw, NGW, lane, (const float*)(ws + WS_QC), 4, XSAMP);
    SEAM(10);
    if (IN(11)) { pg8::Gemm g{H, (const bf16*)(ws + WS_W13B), T, 2 * FF, DM}; pg8::StaticOrder S; S.init(T, 2 * FF, G_, (int)blockIdx.x, DM); pg8::EpiSwiGLU E{ACT, FF};
        pg8::gemm_phase<pg8::EpiSwiGLU, pg8::StaticOrder, true, true>(lds, g, S, E); }
    SEAM(11);
    if (IN(12)) { pg8::Gemm g{ACT, (const bf16*)(ws + WS_W2B), T, DM, FF}; pg8::TailOrder S; S.init(TP, TS, DM, G_, (int)blockIdx.x, FF, 11); pg8::EpiResB<1> E{XS, H, (float*)(ws + WS_QC)};
        pg8::gemm_phase<pg8::EpiResB<1>, pg8::TailOrder, true, true, true>(lds, g, S, E); }
    SEAM(12);
    if (IN(13)) {
        const bf16* X3 = H; const float* slab = (const float*)(ws + WS_QC); float* Y = out + O_Y;
        f32x4 g[4];
#pragma unroll
        for (int j = 0; j < 4; ++j) g[j] = ((const f32x4*)P.in[24])[lane + 64 * j];
        u32x2 nb[4]; f32x4 nf[4];
#define FN_LOAD(mm) do { const int mm_ = (mm); if (mm_ < TP) { _Pragma("unroll") for (int j = 0; j < 4; ++j) nb[j] = ((const u32x2*)(X3 + (size_t)mm_ * DM))[lane + 64 * j]; } \
            else if (mm_ < T) { _Pragma("unroll") for (int j = 0; j < 4; ++j) nf[j] = ((const f32x4*)(XSAMP + (size_t)(mm_ - TP) * DM))[lane + 64 * j]; } } while (0)
        FN_LOAD(gw);
        for (int m = gw; m < T; m += NGW) { f32x4 v[4];
            if (m < TP) {
#pragma unroll
                for (int j = 0; j < 4; ++j) { v[j].x = bflo(nb[j].x); v[j].y = bfhi(nb[j].x); v[j].z = bflo(nb[j].y); v[j].w = bfhi(nb[j].y); } }
            else {
#pragma unroll
                for (int j = 0; j < 4; ++j) v[j] = nf[j]; }
            FN_LOAD(m + NGW);
            if (m >= TP) for (int kp = 0; kp < 11; ++kp) { const f32x4* sp = (const f32x4*)(slab + ((size_t)kp * 1024 + (m - TP)) * DM);
#pragma unroll
                for (int j = 0; j < 4; ++j) v[j] += sp[lane + 64 * j]; }
            float sq = 0.f;
#pragma unroll
            for (int j = 0; j < 4; ++j) sq += (v[j].x * v[j].x + v[j].y * v[j].y) + (v[j].z * v[j].z + v[j].w * v[j].w);
            sq = wave_sum(sq); const float rstd = 1.0f / sqrtf(sq * (1.0f / DM) + 1e-6f);
#pragma unroll
            for (int j = 0; j < 4; ++j) ((f32x4*)(Y + (size_t)m * DM))[lane + 64 * j] = v[j] * rstd * g[j]; }
#undef FN_LOAD
    }
#undef IN
#undef SEAM
}

#ifndef PROBE_PH
#define PROBE_PH -1
#define PROBE_REP 3
#endif
#ifndef N_LAUNCH_MODE
#define N_LAUNCH_MODE 0
#endif
extern "C" void kernel_launch(void* const* d_in, const int* in_sizes, int n_in, void* d_out, int out_size, void* d_ws, size_t ws_size, hipStream_t stream) {
    static int grid = 0;
    if (grid == 0) {
        if (n_in != 25 || out_size != (int)O_END || ws_size < WS_END) { fprintf(stderr, "kernel_launch: unexpected shapes n_in %d out %d ws %zu\n", n_in, out_size, ws_size); grid = -1; return; }
        int dev = 0, cus = 0, per_cu = 0;
        hipGetDevice(&dev); hipDeviceGetAttribute(&cus, hipDeviceAttributeMultiprocessorCount, dev);
        if (hipFuncSetAttribute((const void*)fwd_kernel, hipFuncAttributeMaxDynamicSharedMemorySize, LDS_BYTES) != hipSuccess) { fprintf(stderr, "kernel_launch: hipFuncSetAttribute failed\n"); grid = -1; return; }
        if (hipOccupancyMaxActiveBlocksPerMultiprocessor(&per_cu, (const void*)fwd_kernel, NTHR, LDS_BYTES) != hipSuccess || per_cu < 1) { fprintf(stderr, "kernel_launch: occupancy query says %d\n", per_cu); per_cu = 1; }
        (void)hipGetLastError();
        grid = cus * 1;
    }
    if (grid < 0) return;
    Ptrs p{};
    for (int i = 0; i < 25; ++i) p.in[i] = (const float*)d_in[i];
    p.out = (float*)d_out; p.ws = (unsigned char*)d_ws;
#if N_LAUNCH_MODE == 1
    for (int ph = 0; ph < 14; ++ph) { const int nrep = (ph == PROBE_PH) ? PROBE_REP : 1;
        for (int r = 0; r < nrep; ++r) { p.ph_lo = ph; p.ph_hi = ph + 1; p.coop = 0; hipLaunchKernelGGL(fwd_kernel, dim3(grid), dim3(NTHR), LDS_BYTES, stream, p); } }
#else
    if (hipMemsetAsync((char*)d_ws + WS_CTL, 0, CTL_BYTES, stream) != hipSuccess) { fprintf(stderr, "kernel_launch: memset failed\n"); return; }
    p.ph_lo = 0; p.ph_hi = 14; p.coop = 1;
    void* args[] = {&p};
    hipError_t e = hipLaunchCooperativeKernel((const void*)fwd_kernel, dim3(grid), dim3(NTHR), args, LDS_BYTES, stream);
    if (e != hipSuccess) fprintf(stderr, "kernel_launch: cooperative launch failed: %s (grid %d)\n", hipGetErrorString(e), grid);
#endif
}
```

```cpp
#include <hip/hip_runtime.h>
#include <hip/hip_cooperative_groups.h>
#include <cstdio>
#include <cstdint>
namespace cg = cooperative_groups;
namespace pg8 {
#define PG8_LAS __attribute__((address_space(3)))
typedef unsigned short bf16_t;
typedef short bf16x8 __attribute__((ext_vector_type(8)));
typedef float f32x4 __attribute__((ext_vector_type(4)));
typedef unsigned u32x4 __attribute__((ext_vector_type(4)));
typedef unsigned u32x2 __attribute__((ext_vector_type(2)));
constexpr int BM = 256, BK = 64, HALF = 128, HTB = HALF * BK * 2  , STAGE_BYTES = 8 * HTB, NXCD = 8, WGM = 8;

__host__ __device__ __forceinline__ int lds_byte(int r, int c) { const int st = (r >> 4) * 2 + (c >> 5), rr = r & 15, cc = c & 31, ob = rr * 64 + cc * 2; return st * 1024 + (ob ^ (((ob >> 9) & 1) << 5)); }
__host__ __device__ __forceinline__ void stage_rc(int b, int& R, int& C) { const int st = b / 1024, sb = b % 1024, swz = sb ^ (((sb >> 9) & 1) << 5); R = (st >> 1) * 16 + swz / 64; C = (st & 1) * 32 + (swz % 64) / 2; }
__host__ __device__ __forceinline__ int perm32(int rho) { const int n = rho >> 4, i = rho & 15; return 8 * (i >> 2) + 4 * n + (i & 3); }

struct Unit { int pm, pn, k0, nt, kp; };
struct Gemm { const bf16_t* A; const bf16_t* Bt; int M, N, K; };

struct StaticOrder {
    int nM, nN, nwg, G, c, ntK;
    __host__ __device__ void init(int M, int N, int G_, int c_, int K_) { nM = M / BM; nN = N / BM; nwg = nM * nN; G = G_; c = c_; ntK = K_ / BK; }
    __host__ __device__ bool next(int i, Unit& u) const {
        const long L = (long)i * G + c; if (L >= nwg) return false;
        int wgid = (int)L; { const int q = nwg / NXCD, r = nwg % NXCD, xcd = wgid % NXCD, off = wgid / NXCD; wgid = (xcd < r ? xcd * (q + 1) : r * (q + 1) + (xcd - r) * q) + off; }
        const int nig = WGM * nN, gid = wgid / nig, fm = gid * WGM, gsz = (nM - fm) < WGM ? (nM - fm) : WGM;
        u.pm = fm + ((wgid % nig) % gsz); u.pn = (wgid % nig) / gsz; u.k0 = 0; u.nt = ntK; u.kp = -1; return true;
    }
    __device__ __forceinline__ void a_ready(const Unit&) const {}
    __device__ __forceinline__ void done(const Unit&) const {}
};

struct TailOrder {
    StaticOrder so; int nTailM, nsplit, ntPiece, nMain, G, c;
    __host__ __device__ void init(int Mmain, int Mtail, int N, int G_, int c_, int K_, int nsplit_) { so.init(Mmain, N, G_, c_, K_); nMain = so.nwg; nTailM = Mtail / BM; nsplit = nsplit_; ntPiece = (K_ / BK) / nsplit_; G = G_; c = c_; }
    __host__ __device__ bool next(int i, Unit& u) const {
        const long L = (long)i * G + c;
        if (L < nMain) return so.next(i, u);
        const int sidx = (int)(L - nMain); if (sidx >= nTailM * so.nN * nsplit) return false;
        const int tile = sidx / nsplit, kp = sidx % nsplit; u.pm = so.nM + tile / so.nN; u.pn = tile % so.nN; u.k0 = kp * ntPiece * BK; u.nt = ntPiece; u.kp = kp; return true;
    }
    __device__ __forceinline__ void a_ready(const Unit&) const {}
    __device__ __forceinline__ void done(const Unit&) const {}
};
__device__ __forceinline__ unsigned cvt_pk_bf16(float lo, float hi) { unsigned r; asm volatile("v_cvt_pk_bf16_f32 %0, %1, %2" : "=v"(r) : "v"(lo), "v"(hi)); return r; }
typedef float f32x2 __attribute__((ext_vector_type(2)));
__device__ __forceinline__ float silu_f(float x) { return x * __builtin_amdgcn_rcpf(1.f + __expf(-x)); }
__device__ __forceinline__ float sigmoid_f(float x) { return __builtin_amdgcn_rcpf(1.f + __expf(-x)); }
constexpr int E_TP = 32768, E_T = 33792;
struct EpiSwiGLU {
    static constexpr bool PERM = true, AFTER_DRAIN = false;
    bf16_t* O; int ldc;
    __device__ __forceinline__ void operator()(const f32x4 (&acc)[2][2][4][2], const Unit& u, int wr, int wc, int fr, int fq) const {
        const int row0 = u.pm * BM + wr * 64 + fr; const int col0 = u.pn * HALF + wc * 32 + 8 * fq;
#pragma unroll
        for (int ai = 0; ai < 2; ++ai)
#pragma unroll
            for (int m = 0; m < 4; ++m) { const int rr = wr * 64 + fr + ai * HALF + m * 16;
                bf16_t* rowp = O + (size_t)u.pm * 256 * ldc + (size_t)(col0 >> 6) * 16384 + rr * 64 + (col0 & 63);
                const f32x4 g0 = acc[ai][0][m][0], g1 = acc[ai][0][m][1], u0 = acc[ai][1][m][0], u1 = acc[ai][1][m][1];
                float v[8];
#pragma unroll
                for (int j = 0; j < 4; ++j) { v[j] = silu_f(g0[j]) * u0[j]; v[4 + j] = silu_f(g1[j]) * u1[j]; }
                u32x4 w; w.x = cvt_pk_bf16(v[0], v[1]); w.y = cvt_pk_bf16(v[2], v[3]); w.z = cvt_pk_bf16(v[4], v[5]); w.w = cvt_pk_bf16(v[6], v[7]);
                *(u32x4*)rowp = w; }
    }
};
struct EpiZ {
    static constexpr bool PERM = true, AFTER_DRAIN = false;
    bf16_t* Z; float* kp; float* ks; bf16_t* KF;
    __device__ __forceinline__ void operator()(const f32x4 (&acc)[2][2][4][2], const Unit& u, int wr, int wc, int fr, int fq) const {
        const int row0 = u.pm * BM + wr * 64 + fr; const int colt = u.pn * BM + wc * 32 + 8 * fq;
        const bool sig = (u.pn >= 10);
        const bool kout = (u.pn == 2 || u.pn == 3) && (u.pm >= 128 || (u.pm & 63) >= 62);
#pragma unroll
        for (int ai = 0; ai < 2; ++ai)
#pragma unroll
            for (int m = 0; m < 4; ++m) { const int row = row0 + ai * HALF + m * 16;
#pragma unroll
                for (int bj = 0; bj < 2; ++bj) { const int col = colt + bj * HALF; f32x4 v0 = acc[ai][bj][m][0], v1 = acc[ai][bj][m][1];
                    if (sig) {
#pragma unroll
                        for (int j = 0; j < 4; ++j) { v0[j] = sigmoid_f(v0[j]); v1[j] = sigmoid_f(v1[j]); } }
                    u32x4 w; w.x = cvt_pk_bf16(v0[0], v0[1]); w.y = cvt_pk_bf16(v0[2], v0[3]); w.z = cvt_pk_bf16(v1[0], v1[1]); w.w = cvt_pk_bf16(v1[2], v1[3]);
                    if (u.pn == 2 || u.pn == 3) { const int cc = col - 512, hh = cc >> 6, dd = cc & 63;
                        *(u32x4*)(KF + ((((size_t)(row >> 5) * 8 + hh) * 4 + (dd >> 4)) * 64 + ((dd >> 3) & 1) * 32 + (row & 31)) * 8) = w; }
                    else *(u32x4*)(Z + (size_t)row * 3072 + col) = w;
                    if (kout) { float* dst = (u.pm >= 128) ? ks + (size_t)(row - E_TP) * 512 + (col - 512)
                                                           : kp + (size_t)((row >> 14) * 512 + ((row & 16383) - 15872)) * 512 + (col - 512);
                        *(f32x4*)dst = v0; *(f32x4*)(dst + 4) = v1; } } }
    }
};
struct EpiVT {
    static constexpr bool PERM = true, AFTER_DRAIN = false;
    bf16_t* VT; float* vp; float* vs;
    __device__ __forceinline__ void operator()(const f32x4 (&acc)[2][2][4][2], const Unit& u, int wr, int wc, int fr, int fq) const {
        const int row0 = u.pm * BM + wr * 64 + fr; const int colt = u.pn * BM + wc * 32 + 8 * fq;
        const bool vout = (u.pn >= 128 || (u.pn & 63) >= 62);
#pragma unroll
        for (int ai = 0; ai < 2; ++ai)
#pragma unroll
            for (int m = 0; m < 4; ++m) { const int row = row0 + ai * HALF + m * 16;
#pragma unroll
                for (int bj = 0; bj < 2; ++bj) { const int col = colt + bj * HALF; const f32x4 v0 = acc[ai][bj][m][0], v1 = acc[ai][bj][m][1];
                    u32x4 w; w.x = cvt_pk_bf16(v0[0], v0[1]); w.y = cvt_pk_bf16(v0[2], v0[3]); w.z = cvt_pk_bf16(v1[0], v1[1]); w.w = cvt_pk_bf16(v1[2], v1[3]);
                    { const int hh = row >> 6, dd = row & 63, tl = col & 31;
                      bf16_t* dst = VT + ((((((size_t)(col >> 5) * 8 + hh) * 2 + (dd >> 5)) * 2 + (tl >> 4)) * 64 + (dd & 31)) * 8) + ((tl >> 3) & 1) * 4;
                      u32x2 w0; w0.x = w.x; w0.y = w.y; u32x2 w1; w1.x = w.z; w1.y = w.w;
                      *(u32x2*)dst = w0; *(u32x2*)(dst + 32 * 8) = w1; }
                    if (vout) {
#pragma unroll
                        for (int j = 0; j < 8; ++j) { const int tok = col + j; const float val = j < 4 ? v0[j & 3] : v1[j & 3];
                            float* dst = (u.pn >= 128) ? vs + (size_t)(tok - E_TP) * 512 + row
                                                       : vp + (size_t)((tok >> 14) * 512 + ((tok & 16383) - 15872)) * 512 + row;
                            *dst = val; } } } }
    }
};
struct EpiResIn {
    static constexpr bool PERM = false, AFTER_DRAIN = false; static constexpr float scale = 0.5f;
    const float* xp; const float* xs; bf16_t* outb; float* slab;
    __device__ __forceinline__ void operator()(const f32x4 (&acc)[2][2][4][2], const Unit& u, int wr, int wc, int fr, int fq) const {
        const int row0 = u.pm * BM + wr * 64 + fr; const int col0 = u.pn * BM + wc * 32 + 4 * fq;
        if (u.kp >= 0) {
#pragma unroll
            for (int ai = 0; ai < 2; ++ai)
#pragma unroll
                for (int m = 0; m < 4; ++m) { const int row = row0 + ai * HALF + m * 16; float* sp = slab + ((size_t)u.kp * 1024 + (row - E_TP)) * 1024;
#pragma unroll
                    for (int bj = 0; bj < 2; ++bj)
#pragma unroll
                        for (int n = 0; n < 2; ++n) *(f32x4*)(sp + col0 + bj * HALF + n * 16) = acc[ai][bj][m][n] * scale; }
            return; }
#pragma unroll
        for (int ai = 0; ai < 2; ++ai) { f32x4 b[4][2][2];
#pragma unroll
            for (int m = 0; m < 4; ++m) { const int row = row0 + ai * HALF + m * 16;
                const float* bp = row < E_TP ? xp + (size_t)row * 1024 : xs + (size_t)(row - E_TP) * 1024;
#pragma unroll
                for (int bj = 0; bj < 2; ++bj)
#pragma unroll
                    for (int n = 0; n < 2; ++n) b[m][bj][n] = *(const f32x4*)(bp + col0 + bj * HALF + n * 16); }
            asm volatile("" ::: "memory");
#pragma unroll
            for (int m = 0; m < 4; ++m) { bf16_t* op = outb + (size_t)(row0 + ai * HALF + m * 16) * 1024;
#pragma unroll
                for (int bj = 0; bj < 2; ++bj)
#pragma unroll
                    for (int n = 0; n < 2; ++n) { const f32x4 o = b[m][bj][n] + acc[ai][bj][m][n] * scale; u32x2 w; w.x = cvt_pk_bf16(o[0], o[1]); w.y = cvt_pk_bf16(o[2], o[3]);
                        *(u32x2*)(op + col0 + bj * HALF + n * 16) = w; } }
            asm volatile("" ::: "memory"); }
    }
};
template <int SC2> struct EpiResB {
    static constexpr bool PERM = false, AFTER_DRAIN = false; static constexpr float scale = 0.5f * SC2;
    const bf16_t* base; bf16_t* outb; float* slab;
    __device__ __forceinline__ void operator()(const f32x4 (&acc)[2][2][4][2], const Unit& u, int wr, int wc, int fr, int fq) const {
        const int row0 = u.pm * BM + wr * 64 + fr; const int col0 = u.pn * BM + wc * 32 + 4 * fq;
        if (u.kp >= 0) {
#pragma unroll
            for (int ai = 0; ai < 2; ++ai)
#pragma unroll
                for (int m = 0; m < 4; ++m) { const int row = row0 + ai * HALF + m * 16; float* sp = slab + ((size_t)u.kp * 1024 + (row - E_TP)) * 1024;
#pragma unroll
                    for (int bj = 0; bj < 2; ++bj)
#pragma unroll
                        for (int n = 0; n < 2; ++n) *(f32x4*)(sp + col0 + bj * HALF + n * 16) = acc[ai][bj][m][n] * scale; }
            return; }
        u32x2 b[2][4][2][2];
#pragma unroll
        for (int ai = 0; ai < 2; ++ai)
#pragma unroll
            for (int m = 0; m < 4; ++m) { const bf16_t* bp = base + (size_t)(row0 + ai * HALF + m * 16) * 1024;
#pragma unroll
                for (int bj = 0; bj < 2; ++bj)
#pragma unroll
                    for (int n = 0; n < 2; ++n) b[ai][m][bj][n] = *(const u32x2*)(bp + col0 + bj * HALF + n * 16); }
        asm volatile("" ::: "memory");
#pragma unroll
        for (int ai = 0; ai < 2; ++ai)
#pragma unroll
            for (int m = 0; m < 4; ++m) { bf16_t* op = outb + (size_t)(row0 + ai * HALF + m * 16) * 1024;
#pragma unroll
                for (int bj = 0; bj < 2; ++bj)
#pragma unroll
                    for (int n = 0; n < 2; ++n) { const u32x2 bb = b[ai][m][bj][n]; f32x4 o;
                        o[0] = __uint_as_float(bb.x << 16); o[1] = __uint_as_float(bb.x & 0xffff0000u); o[2] = __uint_as_float(bb.y << 16); o[3] = __uint_as_float(bb.y & 0xffff0000u);
                        o = o + acc[ai][bj][m][n] * scale; u32x2 w; w.x = cvt_pk_bf16(o[0], o[1]); w.y = cvt_pk_bf16(o[2], o[3]);
                        *(u32x2*)(op + col0 + bj * HALF + n * 16) = w; } }
    }
};
template <int SC2> struct EpiRes {
    static constexpr bool PERM = false, AFTER_DRAIN = false; static constexpr float scale = 0.5f * SC2;
    const float* xp; const float* xs; float* out; float* slab;
    __device__ __forceinline__ void operator()(const f32x4 (&acc)[2][2][4][2], const Unit& u, int wr, int wc, int fr, int fq) const {
        const int row0 = u.pm * BM + wr * 64 + fr; const int col0 = u.pn * BM + wc * 32 + 4 * fq;
        if (u.kp >= 0) {
#pragma unroll
            for (int ai = 0; ai < 2; ++ai)
#pragma unroll
                for (int m = 0; m < 4; ++m) { const int row = row0 + ai * HALF + m * 16; float* sp = slab + ((size_t)u.kp * 1024 + (row - E_TP)) * 1024;
#pragma unroll
                    for (int bj = 0; bj < 2; ++bj)
#pragma unroll
                        for (int n = 0; n < 2; ++n) *(f32x4*)(sp + col0 + bj * HALF + n * 16) = acc[ai][bj][m][n] * scale; }
            return; }
#pragma unroll
        for (int ai = 0; ai < 2; ++ai) { f32x4 b[4][2][2];
#pragma unroll
            for (int m = 0; m < 4; ++m) { const int row = row0 + ai * HALF + m * 16;
                const float* bp = xp ? (row < E_TP ? xp + (size_t)row * 1024 : xs + (size_t)(row - E_TP) * 1024) : out + (size_t)row * 1024;
#pragma unroll
                for (int bj = 0; bj < 2; ++bj)
#pragma unroll
                    for (int n = 0; n < 2; ++n) b[m][bj][n] = *(const f32x4*)(bp + col0 + bj * HALF + n * 16); }
            asm volatile("" ::: "memory");
#pragma unroll
            for (int m = 0; m < 4; ++m) { float* op = out + (size_t)(row0 + ai * HALF + m * 16) * 1024;
#pragma unroll
                for (int bj = 0; bj < 2; ++bj)
#pragma unroll
                    for (int n = 0; n < 2; ++n) *(f32x4*)(op + col0 + bj * HALF + n * 16) = b[m][bj][n] + acc[ai][bj][m][n] * scale; }
            asm volatile("" ::: "memory"); }
    }
};
template <class Epi, class Sched, bool ALIGN_EPI = false, bool SP2 = false, bool PK = false>
__device__ __forceinline__ void gemm_phase(PG8_LAS unsigned char* lds, const Gemm g, const Sched& S, const Epi& E) {
    const int tid = threadIdx.x, wid = __builtin_amdgcn_readfirstlane(tid >> 6), lane = tid & 63, wr = wid >> 2, wc = wid & 3, fr = lane & 15, fq = lane >> 4;
    const int K = g.K;
    unsigned voffA[2], voffB[2];
#pragma unroll
    for (int i = 0; i < 2; ++i) { int R, C; stage_rc(tid * 16 + i * 8192, R, C); const int Rb = Epi::PERM ? ((R & ~31) + perm32(R & 31)) : R;
        voffA[i] = (unsigned)(R * (PK ? BK : K) + C) * 2u; voffB[i] = (unsigned)(Rb * (PK ? BK : K) + C) * 2u; }
    const size_t kstep = PK ? (size_t)(BM * BK * 2) : (size_t)(BK * 2);
    const size_t hstep = PK ? (size_t)(HALF * BK * 2) : (size_t)HALF * K * 2;
    const size_t tstep = (size_t)BM * K * 2;
    const unsigned ldsw = (unsigned)wid * 1024u;
    const int aoff = lds_byte(wr * 64 + fr, fq * 8), boff = lds_byte(wc * 32 + fr, fq * 8);
#define PG8_SA(b, h) (((b) * 2 + (h)) * HTB)
#define PG8_SB(b, h) ((4 + (b) * 2 + (h)) * HTB)
#define PG8_STAGE(bufoff, gbase, voff) do { _Pragma("unroll") for (int _i = 0; _i < 2; ++_i) \
        __builtin_amdgcn_global_load_lds((const unsigned*)((const char*)(gbase) + (voff)[_i]), (PG8_LAS unsigned*)(lds + (bufoff) + ldsw + _i * 8192), 16, 0, 0); } while (0)
#define PG8_LDA(dst, b, h) do { _Pragma("unroll") for (int m = 0; m < 4; ++m) _Pragma("unroll") for (int k = 0; k < 2; ++k) dst[m][k] = *(const PG8_LAS bf16x8*)(lds + PG8_SA(b, h) + aoff + m * 2048 + k * 1024); } while (0)
#define PG8_LDB(dst, b, h) do { _Pragma("unroll") for (int n = 0; n < 2; ++n) _Pragma("unroll") for (int k = 0; k < 2; ++k) dst[n][k] = *(const PG8_LAS bf16x8*)(lds + PG8_SB(b, h) + boff + n * 2048 + k * 1024); } while (0)
#define PG8_MMA(ai, bj, At, Bt) do { __builtin_amdgcn_s_setprio(1); _Pragma("unroll") for (int m = 0; m < 4; ++m) _Pragma("unroll") for (int n = 0; n < 2; ++n) _Pragma("unroll") for (int k = 0; k < 2; ++k) \
        acc[ai][bj][m][n] = __builtin_amdgcn_mfma_f32_16x16x32_bf16(Bt[n][k], At[m][k], acc[ai][bj][m][n], 0, 0, 0); __builtin_amdgcn_s_setprio(0); } while (0)
#define PG8_WAIT_V(n) asm volatile("s_waitcnt vmcnt(" #n ")" ::: "memory")
#define PG8_WAIT_L(n) asm volatile("s_waitcnt lgkmcnt(" #n ")" ::: "memory")
#define PG8_BAR __builtin_amdgcn_s_barrier()
#define PG8_SCHED __builtin_amdgcn_sched_barrier(0)
    Unit cur, nxt; int ui = 0;
    if (!S.next(0, cur)) return;
    f32x4 acc[2][2][4][2];
#pragma unroll
    for (int a = 0; a < 2; ++a)
#pragma unroll
        for (int b = 0; b < 2; ++b)
#pragma unroll
            for (int m = 0; m < 4; ++m)
#pragma unroll
                for (int n = 0; n < 2; ++n) acc[a][b][m][n] = (f32x4){0.f, 0.f, 0.f, 0.f};
    bf16x8 At[4][2], B0[2][2], B1[2][2];
    const char* cA = (const char*)g.A + (size_t)cur.pm * tstep + (PK ? (size_t)(cur.k0 / BK) * kstep : (size_t)cur.k0 * 2); const char* cB = (const char*)g.Bt + (size_t)cur.pn * tstep + (PK ? (size_t)(cur.k0 / BK) * kstep : (size_t)cur.k0 * 2);
    S.a_ready(cur);
    if constexpr (SP2) {
        PG8_STAGE(PG8_SB(0, 0), cB, voffB); PG8_STAGE(PG8_SB(0, 1), cB + hstep, voffB); PG8_STAGE(PG8_SA(0, 0), cA, voffA); PG8_STAGE(PG8_SA(0, 1), cA + hstep, voffA);
        if (wr == 1) PG8_BAR;
        PG8_WAIT_V(2); PG8_BAR;
        PG8_STAGE(PG8_SB(1, 0), cB + kstep, voffB); PG8_STAGE(PG8_SA(1, 0), cA + kstep, voffA); PG8_STAGE(PG8_SB(1, 1), cB + hstep + kstep, voffB);
        PG8_WAIT_V(6); PG8_BAR;
    } else {
        PG8_STAGE(PG8_SB(0, 0), cB, voffB); PG8_STAGE(PG8_SA(0, 0), cA, voffA); PG8_STAGE(PG8_SB(0, 1), cB + hstep, voffB); PG8_STAGE(PG8_SA(0, 1), cA + hstep, voffA);
        if (wr == 1) PG8_BAR;
        PG8_WAIT_V(4); PG8_BAR;
        PG8_STAGE(PG8_SB(1, 0), cB + kstep, voffB); PG8_STAGE(PG8_SA(1, 0), cA + kstep, voffA); PG8_STAGE(PG8_SB(1, 1), cB + hstep + kstep, voffB);
        PG8_WAIT_V(6); PG8_BAR;
    }
    for (;;) {
        const bool has_next = S.next(ui + 1, nxt);
        const char* nA = has_next ? (const char*)g.A + (size_t)nxt.pm * tstep + (PK ? (size_t)(nxt.k0 / BK) * kstep : (size_t)nxt.k0 * 2) : cA; const char* nB = has_next ? (const char*)g.Bt + (size_t)nxt.pn * tstep + (PK ? (size_t)(nxt.k0 / BK) * kstep : (size_t)nxt.k0 * 2) : cB;
        const int nt = cur.nt;
        for (int t = 0; t < nt; t += 2) {
            const bool last = (t == nt - 2);
            const char* a1 = cA + (size_t)(t + 1) * kstep;
            const char* a2 = last ? nA : cA + (size_t)(t + 2) * kstep; const char* b2 = last ? nB : cB + (size_t)(t + 2) * kstep;
            const char* a3 = a2 + kstep; const char* b3 = b2 + kstep;
            if (last && has_next) S.a_ready(nxt);
            if constexpr (SP2) {
            PG8_LDB(B0, 0, 0); PG8_LDB(B1, 0, 1); PG8_SCHED; PG8_LDA(At, 0, 0); PG8_STAGE(PG8_SA(1, 1), a1 + hstep, voffA);
            PG8_WAIT_V(8); PG8_WAIT_L(0); PG8_BAR; PG8_MMA(0, 0, At, B0); PG8_MMA(0, 1, At, B1); PG8_BAR; PG8_SCHED;
            PG8_LDA(At, 0, 1); PG8_STAGE(PG8_SB(0, 0), b2, voffB); PG8_STAGE(PG8_SB(0, 1), b2 + hstep, voffB); PG8_STAGE(PG8_SA(0, 0), a2, voffA);
            PG8_WAIT_V(8); PG8_WAIT_L(0); PG8_BAR; PG8_MMA(1, 0, At, B0); PG8_MMA(1, 1, At, B1); PG8_BAR; PG8_SCHED;
            PG8_LDB(B0, 1, 0); PG8_LDB(B1, 1, 1); PG8_SCHED; PG8_LDA(At, 1, 0); PG8_STAGE(PG8_SA(0, 1), a2 + hstep, voffA);
            PG8_WAIT_V(8); PG8_WAIT_L(0); PG8_BAR; PG8_MMA(0, 0, At, B0); PG8_MMA(0, 1, At, B1); PG8_BAR; PG8_SCHED;
            PG8_LDA(At, 1, 1); PG8_STAGE(PG8_SB(1, 0), b3, voffB); PG8_STAGE(PG8_SB(1, 1), b3 + hstep, voffB); PG8_STAGE(PG8_SA(1, 0), a3, voffA);
            PG8_WAIT_V(8); PG8_WAIT_L(0); PG8_BAR; PG8_MMA(1, 0, At, B0); PG8_MMA(1, 1, At, B1); PG8_BAR; PG8_SCHED;
            } else {
            PG8_LDB(B0, 0, 0); PG8_SCHED; PG8_LDA(At, 0, 0); PG8_STAGE(PG8_SA(1, 1), a1 + hstep, voffA);
            PG8_WAIT_L(8); PG8_BAR; PG8_WAIT_L(0); PG8_MMA(0, 0, At, B0); PG8_BAR; PG8_SCHED;
            PG8_LDB(B1, 0, 1); PG8_STAGE(PG8_SB(0, 0), b2, voffB);
            PG8_BAR; PG8_WAIT_L(0); PG8_MMA(0, 1, At, B1); PG8_BAR;
            PG8_LDA(At, 0, 1); PG8_STAGE(PG8_SA(0, 0), a2, voffA);
            PG8_BAR; PG8_WAIT_L(0); PG8_MMA(1, 0, At, B0); PG8_BAR; PG8_SCHED;
            PG8_STAGE(PG8_SB(0, 1), b2 + hstep, voffB);
            PG8_WAIT_V(6); PG8_BAR; PG8_MMA(1, 1, At, B1); PG8_BAR;
            PG8_LDB(B0, 1, 0); PG8_SCHED; PG8_LDA(At, 1, 0); PG8_STAGE(PG8_SA(0, 1), a2 + hstep, voffA);
            PG8_WAIT_L(8); PG8_BAR; PG8_WAIT_L(0); PG8_MMA(0, 0, At, B0); PG8_BAR; PG8_SCHED;
            PG8_LDB(B1, 1, 1); PG8_STAGE(PG8_SB(1, 0), b3, voffB);
            PG8_BAR; PG8_WAIT_L(0); PG8_MMA(0, 1, At, B1); PG8_BAR;
            PG8_LDA(At, 1, 1); PG8_STAGE(PG8_SA(1, 0), a3, voffA);
            PG8_BAR; PG8_WAIT_L(0); PG8_MMA(1, 0, At, B0); PG8_BAR; PG8_SCHED;
            PG8_STAGE(PG8_SB(1, 1), b3 + hstep, voffB);
            PG8_WAIT_V(6); PG8_BAR; PG8_MMA(1, 1, At, B1); PG8_BAR;
            }
        }
        if constexpr (ALIGN_EPI) { if (wr == 0) PG8_BAR; }
        if constexpr (!Epi::AFTER_DRAIN) { E(acc, cur, wr, wc, fr, fq); S.done(cur); }
        if (!has_next) break;
#pragma unroll
        for (int a = 0; a < 2; ++a)
#pragma unroll
            for (int b = 0; b < 2; ++b)
#pragma unroll
                for (int m = 0; m < 4; ++m)
#pragma unroll
                    for (int n = 0; n < 2; ++n) acc[a][b][m][n] = (f32x4){0.f, 0.f, 0.f, 0.f};
        cur = nxt; cA = nA; cB = nB; ++ui;
        if constexpr (ALIGN_EPI) { if (wr == 1) PG8_BAR; }
    }
    PG8_WAIT_V(0);
    if constexpr (!ALIGN_EPI) { if (wr == 0) PG8_BAR; }
    PG8_BAR;
    if constexpr (Epi::AFTER_DRAIN) { E.fused(acc, cur, wr, wc, fr, fq, lds, wid, lane); S.done(cur); }
#undef PG8_SA
#undef PG8_SB
#undef PG8_STAGE
#undef PG8_LDA
#undef PG8_LDB
#undef PG8_MMA
#undef PG8_WAIT_V
#undef PG8_WAIT_L
#undef PG8_BAR
#undef PG8_SCHED
}
}
#define LAS __attribute__((address_space(3)))
typedef unsigned short bf16;
typedef short bf16x8 __attribute__((ext_vector_type(8)));
typedef float f32x4 __attribute__((ext_vector_type(4)));
typedef float f32x16 __attribute__((ext_vector_type(16)));
typedef unsigned u32x4 __attribute__((ext_vector_type(4)));
typedef unsigned u32x2 __attribute__((ext_vector_type(2)));
typedef float f32x2_t __attribute__((ext_vector_type(2)));
typedef __bf16 bf16x2_t __attribute__((ext_vector_type(2)));

constexpr int TP = 32768, TS = 1024, T = TP + TS, DM = 1024, FF = 2816, NZ = 3072;
constexpr int NU_P = 2048, NU_S = 128, NU = NU_P + NU_S;
constexpr int NWAVES = 8, NTHR = 512;
constexpr size_t MiB = 1u << 20;
constexpr size_t WS_CTL = 0, CTL_BYTES = 1 * MiB;
constexpr size_t WS_W13A = 2 * MiB, WS_W2A = 13 * MiB, WS_WIN = 19 * MiB, WS_WV = 25 * MiB, WS_WOUT = 26 * MiB, WS_W13B = 28 * MiB, WS_W2B = 39 * MiB;
constexpr size_t WS_H = 46 * MiB;
constexpr size_t WS_BIG = 112 * MiB;
constexpr size_t WS_VT = 310 * MiB;
constexpr size_t WS_G = 343 * MiB;
constexpr size_t WS_QC = 345 * MiB, WS_KC = 378 * MiB;
constexpr size_t WS_DC = 411 * MiB;
constexpr size_t WS_DN = 46661632;
constexpr size_t WS_SC = WS_DN + 1114112;
constexpr size_t WS_KF = 479 * MiB;
constexpr size_t WS_END = 512 * MiB;
constexpr size_t O_Y = 0, O_KP = 34603008, O_VP = 35127296, O_CP = 35651584, O_NP = 35782656, O_MP = 35783680, O_CVP = 35783688,
                 O_KS = 35789832, O_VS = 36314120, O_CS = 36838408, O_NS = 38935560, O_MS = 38951944, O_CVS = 38952072, O_END = 39050376;
constexpr int LDS_BYTES = 147456;

__device__ __forceinline__ unsigned pk2(float lo, float hi) { f32x2_t v = {lo, hi}; bf16x2_t b = __builtin_convertvector(v, bf16x2_t); return __builtin_bit_cast(unsigned, b); }
__device__ __forceinline__ float bflo(unsigned u) { return __uint_as_float(u << 16); }
__device__ __forceinline__ float bfhi(unsigned u) { return __uint_as_float(u & 0xffff0000u); }
__device__ __forceinline__ float bf2f(bf16 b) { return __uint_as_float((unsigned)b << 16); }
__device__ __forceinline__ bf16 f2bf(float f) { return (bf16)(pk2(f, 0.f) & 0xffffu); }
__device__ __forceinline__ float wave_sum(float v) {
#pragma unroll
    for (int o = 1; o < 64; o <<= 1) v += __shfl_xor(v, o);
    return v;
}
__device__ __forceinline__ float wave_max(float v) {
#pragma unroll
    for (int o = 1; o < 64; o <<= 1) v = fmaxf(v, __shfl_xor(v, o));
    return v;
}
__device__ __forceinline__ int crow(int r, int hi) { return (r & 3) + 8 * (r >> 2) + 4 * hi; }
#define MFMA32(a, b, c) __builtin_amdgcn_mfma_f32_32x32x16_bf16((a), (b), (c), 0, 0, 0)
__device__ __forceinline__ bf16x8 pack8f(const float* x) { u32x4 p; p.x = pk2(x[0], x[1]); p.y = pk2(x[2], x[3]); p.z = pk2(x[4], x[5]); p.w = pk2(x[6], x[7]); return __builtin_bit_cast(bf16x8, p); }
__device__ __forceinline__ float silu(float x) { return x * __builtin_amdgcn_rcpf(1.f + __expf(-x)); }
__device__ __forceinline__ float log_sigmoid(float x) { return fminf(x, 0.f) - log1pf(__expf(-fabsf(x))); }

__device__ __forceinline__ void transpose_item(const float* W, int ldn, int K, bf16* WTrow0, int k0, int n0, LAS float* scr, int lane, bool packed = false) {
#pragma unroll 8
    for (int i = 0; i < 32; ++i) { const int kk = 2 * i + (lane >> 5); scr[kk * 33 + (lane & 31)] = W[(size_t)(k0 + kk) * ldn + n0 + (lane & 31)]; }
    asm volatile("s_waitcnt lgkmcnt(0)" ::: "memory");
    const int c = lane & 7;
#pragma unroll
    for (int j = 0; j < 4; ++j) { const int n = (lane >> 3) + 8 * j; const LAS float* s = scr + (8 * c) * 33 + n;
        u32x4 o; o.x = pk2(s[0 * 33], s[1 * 33]); o.y = pk2(s[2 * 33], s[3 * 33]); o.z = pk2(s[4 * 33], s[5 * 33]); o.w = pk2(s[6 * 33], s[7 * 33]);
        if (packed) *(u32x4*)(WTrow0 + (size_t)(n0 >> 8) * 256 * K + (size_t)(k0 >> 6) * 16384 + ((n0 & 255) + n) * 64 + 8 * c) = o;
        else *(u32x4*)(WTrow0 + (size_t)n * K + k0 + 8 * c) = o; }
    asm volatile("s_waitcnt lgkmcnt(0)" ::: "memory");
}
struct Ptrs { const float* in[25]; float* out; unsigned char* ws; int ph_lo, ph_hi, coop, pad; };

__device__ __forceinline__ void p0_weights(const Ptrs& P, LAS float* scr, int gw, int NGW, int lane, int it_lo, int it_hi, int it_skip_lo, int it_skip_hi) {
    constexpr int I_F = 1408, I_IN = 1792, I_OUT = 512;
    constexpr int NIT = 6 * I_F + I_IN + I_OUT;
    unsigned char* ws = P.ws;
    for (int it0 = it_lo + gw; it0 < it_hi; it0 += NGW) {
        const int it = it0 >= it_skip_lo ? it0 + (it_skip_hi - it_skip_lo) : it0; if (it >= NIT) break;
        int r = it;
        if (r < 6 * I_F) {
            const int f = r / (3 * I_F); r -= f * 3 * I_F;
            const int mt = r / I_F; r -= mt * I_F;
            bf16* W13 = (bf16*)(ws + (f ? WS_W13B : WS_W13A)); bf16* W2 = (bf16*)(ws + (f ? WS_W2B : WS_W2A));
            const int base = f ? 21 : 9;
            if (mt < 2) { const int kb = r / 88, nb = r % 88, n0 = nb * 32;
                transpose_item(P.in[base + mt], FF, DM, W13 + (size_t)((n0 >> 7) * 256 + mt * 128 + (n0 & 127)) * DM, kb * 64, n0, scr, lane); }
            else { const int kb = r / 32, nb = r % 32, n0 = nb * 32;
                transpose_item(P.in[base + 2], DM, FF, W2, kb * 64, n0, scr, lane, true); }
            continue;
        }
        r -= 6 * I_F;
        if (r < I_IN) { const int kb = r / 112, nb = r % 112, n0 = nb * 32;
            bf16* dst = n0 < 1024 ? (bf16*)(ws + WS_WIN) + (size_t)n0 * DM : n0 < 1536 ? (bf16*)(ws + WS_WV) + (size_t)(n0 - 1024) * DM : (bf16*)(ws + WS_WIN) + (size_t)(n0 - 512) * DM;
            transpose_item(P.in[13], 3592, DM, dst, kb * 64, n0, scr, lane); continue; }
        r -= I_IN;
        { const int kb = r / 32, nb = r % 32, n0 = nb * 32; transpose_item(P.in[19], DM, DM, (bf16*)(ws + WS_WOUT) + (size_t)n0 * DM, kb * 64, n0, scr, lane); }
    }
}

template <int MODE>
__device__ __forceinline__ void rms_rows(const float* xp, const float* xs, const float* gain, bf16* H, float* outf, const LAS float* gwl, const float* gbias, float* G, int gw, int NGW, int lane, const float* slab, int nsplit, float* xwb) {
    f32x4 g[4];
#pragma unroll
    for (int j = 0; j < 4; ++j) g[j] = ((const f32x4*)gain)[lane + 64 * j];
    f32x4 vn[4];
    if (gw < T) { const float* xr0 = (xs && gw >= TP) ? xs + (size_t)(gw - TP) * DM : xp + (size_t)gw * DM;
#pragma unroll
        for (int j = 0; j < 4; ++j) vn[j] = ((const f32x4*)xr0)[lane + 64 * j]; }
    for (int m = gw; m < T; m += NGW) {
        f32x4 v[4]; float s = 0.f;
#pragma unroll
        for (int j = 0; j < 4; ++j) v[j] = vn[j];
        { const int mn = m + NGW; if (mn < T) { const float* xrn = (xs && mn >= TP) ? xs + (size_t)(mn - TP) * DM : xp + (size_t)mn * DM;
#pragma unroll
            for (int j = 0; j < 4; ++j) vn[j] = ((const f32x4*)xrn)[lane + 64 * j]; } }
        if (nsplit && m >= TP) {
            for (int kp = 0; kp < nsplit; ++kp) { const f32x4* sp = (const f32x4*)(slab + ((size_t)kp * 1024 + (m - TP)) * DM);
#pragma unroll
                for (int j = 0; j < 4; ++j) v[j] += sp[lane + 64 * j]; }
            if (MODE != 2) {
#pragma unroll
                for (int j = 0; j < 4; ++j) ((f32x4*)(xwb + (size_t)m * DM))[lane + 64 * j] = v[j]; }
        }
#pragma unroll
        for (int j = 0; j < 4; ++j) s += (v[j].x * v[j].x + v[j].y * v[j].y) + (v[j].z * v[j].z + v[j].w * v[j].w);
        s = wave_sum(s);
        const float rstd = 1.0f / sqrtf(s * (1.0f / DM) + 1e-6f);
#pragma unroll
        for (int j = 0; j < 4; ++j) v[j] = v[j] * rstd * g[j];
        if (MODE == 2) {
#pragma unroll
            for (int j = 0; j < 4; ++j) ((f32x4*)(outf + (size_t)m * DM))[lane + 64 * j] = v[j];
        } else {
#pragma unroll
            for (int j = 0; j < 4; ++j) { u32x2 w; w.x = pk2(v[j].x, v[j].y); w.y = pk2(v[j].z, v[j].w); ((u32x2*)(H + (size_t)m * DM))[lane + 64 * j] = w; }
        }
        if (MODE == 1) {
            float a8[8];
#pragma unroll
            for (int q = 0; q < 8; ++q) a8[q] = 0.f;
#pragma unroll
            for (int j = 0; j < 4; ++j)
#pragma unroll
                for (int i = 0; i < 4; ++i) { const LAS f32x4* wp = (const LAS f32x4*)(gwl + ((j * 4 + i) * 64 + lane) * 8); const f32x4 w0 = wp[0], w1 = wp[1]; const float xv = v[j][i];
                    a8[0] += xv * w0.x; a8[1] += xv * w0.y; a8[2] += xv * w0.z; a8[3] += xv * w0.w; a8[4] += xv * w1.x; a8[5] += xv * w1.y; a8[6] += xv * w1.z; a8[7] += xv * w1.w; }
#pragma unroll
            for (int q = 0; q < 8; ++q) a8[q] = wave_sum(a8[q]);
            float val = a8[0];
#pragma unroll
            for (int q = 1; q < 8; ++q) val = (lane == q) ? a8[q] : val;
            if (lane < 8) { val += gbias[lane]; if (lane >= 4) val = log_sigmoid(val); G[(size_t)m * 8 + lane] = val; }
        }
    }
}
template <int MODE>
__device__ __forceinline__ void rms_rows_b(bf16* XS, const float* gain, bf16* H, const LAS float* gwl, const float* gbias, float* G, int gw, int NGW, int lane, const float* slab, int nsplit, float* xsamp) {
    f32x4 g[4];
#pragma unroll
    for (int j = 0; j < 4; ++j) g[j] = ((const f32x4*)gain)[lane + 64 * j];
    u32x2 nb[4];
    if (gw < T) {
#pragma unroll
        for (int j = 0; j < 4; ++j) nb[j] = ((const u32x2*)(XS + (size_t)gw * DM))[lane + 64 * j]; }
    for (int m = gw; m < T; m += NGW) {
        f32x4 v[4]; float s = 0.f;
#pragma unroll
        for (int j = 0; j < 4; ++j) { v[j].x = bflo(nb[j].x); v[j].y = bfhi(nb[j].x); v[j].z = bflo(nb[j].y); v[j].w = bfhi(nb[j].y); }
        { const int mn = m + NGW; if (mn < T) {
#pragma unroll
            for (int j = 0; j < 4; ++j) nb[j] = ((const u32x2*)(XS + (size_t)mn * DM))[lane + 64 * j]; } }
        if (m >= TP) {
            for (int kp = 0; kp < nsplit; ++kp) { const f32x4* sp = (const f32x4*)(slab + ((size_t)kp * 1024 + (m - TP)) * DM);
#pragma unroll
                for (int j = 0; j < 4; ++j) v[j] += sp[lane + 64 * j]; }
#pragma unroll
            for (int j = 0; j < 4; ++j) { u32x2 w; w.x = pk2(v[j].x, v[j].y); w.y = pk2(v[j].z, v[j].w); ((u32x2*)(XS + (size_t)m * DM))[lane + 64 * j] = w;
                if (xsamp) ((f32x4*)(xsamp + (size_t)(m - TP) * DM))[lane + 64 * j] = v[j]; }
        }
#pragma unroll
        for (int j = 0; j < 4; ++j) s += (v[j].x * v[j].x + v[j].y * v[j].y) + (v[j].z * v[j].z + v[j].w * v[j].w);
        s = wave_sum(s);
        const float rstd = 1.0f / sqrtf(s * (1.0f / DM) + 1e-6f);
#pragma unroll
        for (int j = 0; j < 4; ++j) v[j] = v[j] * rstd * g[j];
#pragma unroll
        for (int j = 0; j < 4; ++j) { u32x2 w; w.x = pk2(v[j].x, v[j].y); w.y = pk2(v[j].z, v[j].w); ((u32x2*)(H + (size_t)m * DM))[lane + 64 * j] = w; }
        if (MODE == 1) {
            float a8[8];
#pragma unroll
            for (int q = 0; q < 8; ++q) a8[q] = 0.f;
#pragma unroll
            for (int j = 0; j < 4; ++j)
#pragma unroll
                for (int i = 0; i < 4; ++i) { const LAS f32x4* wp = (const LAS f32x4*)(gwl + ((j * 4 + i) * 64 + lane) * 8); const f32x4 w0 = wp[0], w1 = wp[1]; const float xv = v[j][i];
                    a8[0] += xv * w0.x; a8[1] += xv * w0.y; a8[2] += xv * w0.z; a8[3] += xv * w0.w; a8[4] += xv * w1.x; a8[5] += xv * w1.y; a8[6] += xv * w1.z; a8[7] += xv * w1.w; }
#pragma unroll
            for (int q = 0; q < 8; ++q) a8[q] = wave_sum(a8[q]);
            float val = a8[0];
#pragma unroll
            for (int q = 1; q < 8; ++q) val = (lane == q) ? a8[q] : val;
            if (lane < 8) { val += gbias[lane]; if (lane >= 4) val = log_sigmoid(val); G[(size_t)m * 8 + lane] = val; }
        }
    }
}

#define ATT_LOADK(kf, kb_) do { const int kb__ = (kb_); \
        if (kb__ < nkb_cache) { \
            const float* kp = ck + ((size_t)(cb * 512 + kb__ * 32 + r32) * 8 + h) * 64 + hi * 8; \
            _Pragma("unroll") for (int ds = 0; ds < 4; ++ds) { const f32x4 a = *(const f32x4*)(kp + ds * 16), b = *(const f32x4*)(kp + ds * 16 + 4); \
                u32x4 p; p.x = pk2(a.x, a.y); p.y = pk2(a.z, a.w); p.z = pk2(b.x, b.y); p.w = pk2(b.z, b.w); kf[ds] = __builtin_bit_cast(bf16x8, p); } \
        } else { \
            const int kr = krow0 + (kb__ - nkb_cache) * 32; \
            _Pragma("unroll") for (int ds = 0; ds < 4; ++ds) kf[ds] = *(const bf16x8*)(KF + ((((size_t)(kr >> 5) * 8 + h) * 4 + ds) * 64 + lane) * 8); \
        } } while (0)
#define ATT_LOADV(vf, kb_) do { const int kb__ = (kb_); \
        if (kb__ < nkb_cache) { \
            _Pragma("unroll") for (int db = 0; db < 2; ++db) _Pragma("unroll") for (int ks = 0; ks < 2; ++ks) { float t8[8]; \
                _Pragma("unroll") for (int j = 0; j < 8; ++j) { const int key = kb__ * 32 + 16 * ks + 8 * (j >> 2) + 4 * hi + (j & 3); t8[j] = cv[((size_t)(cb * 512 + key) * 8 + h) * 64 + db * 32 + r32]; } \
                vf[db][ks] = pack8f(t8); } \
        } else { \
            const int kr = krow0 + (kb__ - nkb_cache) * 32; \
            _Pragma("unroll") for (int db = 0; db < 2; ++db) _Pragma("unroll") for (int ks = 0; ks < 2; ++ks) vf[db][ks] = *(const bf16x8*)(VT + ((((((size_t)(kr >> 5) * 8 + h) * 2 + db) * 2 + ks) * 64 + lane) * 8)); \
        } } while (0)
__device__ __forceinline__ float xh_max(float v) { auto rr = __builtin_amdgcn_permlane32_swap(__float_as_uint(v), __float_as_uint(v), false, false); return fmaxf(__uint_as_float(rr[0]), __uint_as_float(rr[1])); }
__device__ __forceinline__ float xh_sum(float v) { auto rr = __builtin_amdgcn_permlane32_swap(__float_as_uint(v), __float_as_uint(v), false, false); return __uint_as_float(rr[0]) + __uint_as_float(rr[1]); }
#define ATT_QK(st, kf) do { _Pragma("unroll") for (int qb = 0; qb < NQB; ++qb) { \
            _Pragma("unroll") for (int r = 0; r < 16; ++r) st[qb][r] = 0.f; \
            _Pragma("unroll") for (int ds = 0; ds < 4; ++ds) st[qb] = MFMA32(kf[ds], qf[qb][ds], st[qb]); } } while (0)
#define ATT_SM_PV(st, vf, kb_) do { const int kposb = kpos0 + (kb_) * 32; \
        _Pragma("unroll") for (int qb = 0; qb < NQB; ++qb) { \
            const int qposb = qpos0 + qb * 32; \
            float bm = -1e30f; \
            if (qposb - kposb - 31 >= 128) { const float bias = rb[256]; \
                _Pragma("unroll") for (int r = 0; r < 16; ++r) { st[qb][r] = st[qb][r] * C2 + bias; bm = fmaxf(bm, st[qb][r]); } \
            } else { const int dq = qposb + r32 - kposb; \
                _Pragma("unroll") for (int r = 0; r < 16; ++r) { int d = dq - crow(r, hi); d = d < -128 ? -128 : (d > 128 ? 128 : d); st[qb][r] = st[qb][r] * C2 + rb[d + 128]; bm = fmaxf(bm, st[qb][r]); } \
            } \
            bm = xh_max(bm); \
            const float mnew = fmaxf(mrun[qb], bm), f = __builtin_amdgcn_exp2f(mrun[qb] - mnew); \
            float ps = 0.f; float p[16]; \
            _Pragma("unroll") for (int r = 0; r < 16; ++r) { p[r] = __builtin_amdgcn_exp2f(st[qb][r] - mnew); ps += p[r]; } \
            lrun[qb] = lrun[qb] * f + ps; mrun[qb] = mnew; \
            _Pragma("unroll") for (int db = 0; db < 2; ++db) _Pragma("unroll") for (int r = 0; r < 16; ++r) O[qb][db][r] *= f; \
            const bf16x8 p0 = pack8f(p), p1 = pack8f(p + 8); \
            _Pragma("unroll") for (int db = 0; db < 2; ++db) { O[qb][db] = MFMA32(vf[db][0], p0, O[qb][db]); O[qb][db] = MFMA32(vf[db][1], p1, O[qb][db]); } \
        } } while (0)
template <int NQB>
__device__ __forceinline__ void attn_unit(const bf16* Z, const bf16* KF, const bf16* VT, const float* ck, const float* cv, bf16* MIX, const LAS float* rb,
                                          int h, int qrow0, int krow0, int nkb_cache, int nkb_new, int cb, int qpos0, int kpos0, int lane) {
    const int r32 = lane & 31, hi = lane >> 5; constexpr float C2 = 0.125f * 1.4426950408889634f;
    bf16x8 qf[NQB][4];
#pragma unroll
    for (int qb = 0; qb < NQB; ++qb)
#pragma unroll
        for (int ds = 0; ds < 4; ++ds) qf[qb][ds] = *(const bf16x8*)(Z + (size_t)(qrow0 + qb * 32 + r32) * NZ + h * 64 + ds * 16 + hi * 8);
    float mrun[NQB], lrun[NQB]; f32x16 O[NQB][2];
#pragma unroll
    for (int qb = 0; qb < NQB; ++qb) { mrun[qb] = -1e30f; lrun[qb] = 0.f;
#pragma unroll
        for (int db = 0; db < 2; ++db)
#pragma unroll
            for (int r = 0; r < 16; ++r) O[qb][db][r] = 0.f; }
    const int nkb = nkb_cache + nkb_new;
    bf16x8 kfA[4], kfB[4], vf[2][2]; f32x16 st[NQB];
    ATT_LOADK(kfA, 0);
    for (int kb = 0; kb < nkb; kb += 2) {
        ATT_LOADV(vf, kb);
        if (kb + 1 < nkb) ATT_LOADK(kfB, kb + 1);
        ATT_QK(st, kfA); ATT_SM_PV(st, vf, kb);
        if (kb + 1 < nkb) { ATT_LOADV(vf, kb + 1);
            if (kb + 2 < nkb) ATT_LOADK(kfA, kb + 2);
            ATT_QK(st, kfB); ATT_SM_PV(st, vf, kb + 1); }
    }
#pragma unroll
    for (int qb = 0; qb < NQB; ++qb) {
        const float lt = xh_sum(lrun[qb]); const float inv = 1.0f / lt;
        bf16* op = MIX + (size_t)(qrow0 + qb * 32 + r32) * DM + h * 64 + 4 * hi;
#pragma unroll
        for (int db = 0; db < 2; ++db)
#pragma unroll
            for (int a = 0; a < 4; ++a) { u32x2 w; w.x = pk2(O[qb][db][4 * a] * inv, O[qb][db][4 * a + 1] * inv); w.y = pk2(O[qb][db][4 * a + 2] * inv, O[qb][db][4 * a + 3] * inv);
                *(u32x2*)(op + db * 32 + 8 * a) = w; }
    }
}
#undef ATT_LOADK
#undef ATT_LOADV
#undef ATT_QK
#undef ATT_SM_PV

constexpr int VT_LD = 72;
__device__ __forceinline__ int tix(int row, int col) { return row * VT_LD + ((((col >> 3) ^ (row >> 3)) & 7) << 3) + (col & 7); }
constexpr int ML_WK = 16384, ML_VT = ML_WK + 128 * VT_LD * 2, ML_F = ML_VT + 128 * VT_LD * 2;
__device__ __forceinline__ void unit_gates(const float* G, int row0, int L, int h, int lane, float& b, float& g, float& bL, float& Gmax) {
    const bool valid = lane < L;
    const float ig = valid ? G[(size_t)(row0 + lane) * 8 + h] : 0.f, lf = valid ? G[(size_t)(row0 + lane) * 8 + 4 + h] : 0.f;
    b = lf;
#pragma unroll
    for (int o = 1; o < 64; o <<= 1) { const float x = __shfl_up(b, o); if (lane >= o) b += x; }
    g = valid ? ig - b : -1e30f;
    Gmax = wave_max(g);
    bL = __shfl(b, L - 1);
}
__device__ __forceinline__ void unit_decode(int u, int& row0, int& L, int& h, int& c, int& sb) {
    if (u < NU_P) { const int b = u >> 10; c = (u >> 2) & 255; h = u & 3; row0 = b * 16384 + c * 64; L = 64; sb = -1; }
    else { const int v = u - NU_P; sb = v >> 2; h = v & 3; c = 0; row0 = TP + sb * 32; L = 32; }
}
constexpr int ML_GATE = 57344;
__device__ __forceinline__ void mlstm_m1_phase(const Ptrs& P, LAS unsigned char* lds, int tid, int wave, int lane, int G_) {
    unsigned char* ws = P.ws;
    const bf16* Z = (const bf16*)(ws + WS_BIG); const float* G = (const float*)(ws + WS_G);
    bf16* QC = (bf16*)(ws + WS_QC); bf16* KC = (bf16*)(ws + WS_KC); bf16* DC = (bf16*)(ws + WS_DC); float* DN = (float*)(ws + WS_DN); float* SC = (float*)(ws + WS_SC);
    LAS bf16* wkT = (LAS bf16*)(lds + ML_WK); LAS bf16* vT = (LAS bf16*)(lds + ML_VT); LAS float* gt = (LAS float*)(lds + ML_GATE);
    const int nun = (NU - (int)blockIdx.x + G_ - 1) / G_;
    for (int k = wave; k < nun; k += NWAVES) { const int u = blockIdx.x + k * G_; int row0, L, h, c, sb; unit_decode(u, row0, L, h, c, sb);
        float b, g, bL, Gm; unit_gates(G, row0, L, h, lane, b, g, bL, Gm); LAS float* sWk = gt + (k & 15) * 68; sWk[lane] = (lane < L) ? __expf(g - Gm) : 0.f;
        if (lane == 0) { SC[2 * u] = bL; SC[2 * u + 1] = Gm;
            if (sb >= 0) { const int chn = u - NU_P; const float m = P.in[6][chn], Mx = fmaxf(m, Gm); sWk[64] = __expf(m - Mx); sWk[65] = __expf(Gm - Mx); P.out[O_MS + chn] = bL + Mx; } } }
    const int cg = tid & 31; const bool isk = cg >= 16; const int s0 = tid >> 5; const int vg = tid & 15; const int sv0 = tid >> 4;
    u32x4 zr[4][4], vr[2];
#define M1_LOAD(uu) do { int row0_, L_, h_, c_, sb_; unit_decode((uu), row0_, L_, h_, c_, sb_); const int ch_ = (isk ? 512 : 0) + h_ * 128 + 8 * (cg & 15); const int nit_ = L_ >> 4; \
        _Pragma("unroll") for (int i = 0; i < 4; ++i) if (i < nit_) _Pragma("unroll") for (int j = 0; j < 4; ++j) { const int p = s0 + 16 * i - 3 + j; \
            if (p >= 0 || c_ > 0) zr[i][j] = *(const u32x4*)(Z + (size_t)(row0_ + p) * NZ + 1024 + ch_); \
            else if (sb_ >= 0) { const float* sp = P.in[7] + ((size_t)sb_ * 3 + (3 + p)) * 1024 + ch_; const f32x4 a = *(const f32x4*)sp, b2 = *(const f32x4*)(sp + 4); \
                zr[i][j].x = pk2(a.x, a.y); zr[i][j].y = pk2(a.z, a.w); zr[i][j].z = pk2(b2.x, b2.y); zr[i][j].w = pk2(b2.z, b2.w); } \
            else zr[i][j] = (u32x4){0u, 0u, 0u, 0u}; } \
        _Pragma("unroll") for (int i = 0; i < 2; ++i) if (sv0 + 32 * i < L_) vr[i] = *(const u32x4*)(Z + (size_t)(row0_ + sv0 + 32 * i) * NZ + 2048 + h_ * 128 + 8 * vg); } while (0)
    if (nun > 0) M1_LOAD((int)blockIdx.x);
    LAS float* ctab = (LAS float*)(lds + 65536);
    for (int i = tid; i < 5120; i += NTHR) ctab[i] = i < 4096 ? P.in[14][i] : P.in[15][i - 4096];
    __syncthreads();
    for (int k = 0; k < nun; ++k) { const int u = blockIdx.x + k * G_; int row0, L, h, c, sb; unit_decode(u, row0, L, h, c, sb);
        const int ch = (isk ? 512 : 0) + h * 128 + 8 * (cg & 15); const int nit = L >> 4; const LAS float* sWk = gt + (k & 15) * 68;
        f32x4 w[4][2], bb[2];
        {
#pragma unroll
          for (int j = 0; j < 4; ++j) { w[j][0] = *(const LAS f32x4*)(ctab + j * 1024 + ch); w[j][1] = *(const LAS f32x4*)(ctab + j * 1024 + ch + 4); }
          bb[0] = *(const LAS f32x4*)(ctab + 4096 + ch); bb[1] = *(const LAS f32x4*)(ctab + 4096 + ch + 4); }
#pragma unroll
        for (int i = 0; i < 2; ++i) if (sv0 + 32 * i < L) { const u32x4 r = vr[i]; LAS bf16* d = vT + tix(8 * vg, sv0 + 32 * i);
            d[0] = (bf16)(r.x & 0xffff); d[VT_LD] = (bf16)(r.x >> 16); d[2 * VT_LD] = (bf16)(r.y & 0xffff); d[3 * VT_LD] = (bf16)(r.y >> 16);
            d[4 * VT_LD] = (bf16)(r.z & 0xffff); d[5 * VT_LD] = (bf16)(r.z >> 16); d[6 * VT_LD] = (bf16)(r.w & 0xffff); d[7 * VT_LD] = (bf16)(r.w >> 16); }
#pragma unroll
        for (int i = 0; i < 4; ++i) if (i < nit) { const int s_ = s0 + 16 * i;
            float y[8];
#pragma unroll
            for (int e = 0; e < 4; ++e) { y[e] = bb[0][e]; y[4 + e] = bb[1][e]; }
#pragma unroll
            for (int j = 0; j < 4; ++j) { const u32x4 r = zr[i][j]; float x[8];
                x[0] = bflo(r.x); x[1] = bfhi(r.x); x[2] = bflo(r.y); x[3] = bfhi(r.y); x[4] = bflo(r.z); x[5] = bfhi(r.z); x[6] = bflo(r.w); x[7] = bfhi(r.w);
#pragma unroll
                for (int e = 0; e < 4; ++e) { y[e] += x[e] * w[j][0][e]; y[4 + e] += x[4 + e] * w[j][1][e]; } }
            const float sc = isk ? 0.08838834764831845f : 1.0f;
#pragma unroll
            for (int e = 0; e < 8; ++e) y[e] = silu(y[e]) * sc;
            u32x4 o; o.x = pk2(y[0], y[1]); o.y = pk2(y[2], y[3]); o.z = pk2(y[4], y[5]); o.w = pk2(y[6], y[7]);
            { const int d0 = 8 * (cg & 15), rw = row0 + s_; *(u32x4*)((isk ? KC : QC) + (((size_t)((rw >> 5) * 4 + h) * 8 + (d0 >> 4)) * 64 + ((d0 >> 3) & 1) * 32 + (rw & 31)) * 8) = o; }
            if (isk) { const float wk = sWk[s_];
#pragma unroll
                for (int e = 0; e < 8; ++e) wkT[tix(8 * (cg & 15) + e, s_)] = f2bf(y[e] * wk); }
        }
        __syncthreads();
        if (k + 1 < nun) M1_LOAD(u + G_);
        {
            const int r32 = lane & 31, hi = lane >> 5, eb = wave & 3, dp = wave >> 2; const int nks = L >> 4;
#pragma unroll
            for (int dbi = 0; dbi < 2; ++dbi) { const int db = dp * 2 + dbi; f32x16 acc;
#pragma unroll
                for (int r = 0; r < 16; ++r) acc[r] = 0.f;
#pragma unroll
                for (int ks = 0; ks < 4; ++ks) if (ks < nks) { const bf16x8 A = *(const LAS bf16x8*)(wkT + tix(db * 32 + r32, ks * 16 + hi * 8)), B = *(const LAS bf16x8*)(vT + tix(eb * 32 + r32, ks * 16 + hi * 8));
                    acc = MFMA32(A, B, acc); }
                if (sb < 0) {
#pragma unroll
                    for (int a = 0; a < 4; ++a) { u32x2 wv; wv.x = pk2(acc[4 * a], acc[4 * a + 1]); wv.y = pk2(acc[4 * a + 2], acc[4 * a + 3]);
                        *(u32x2*)(DC + ((((size_t)u * 4 + eb) * 8 + 2 * db + (a >> 1)) * 64 + (a & 1) * 32 + r32) * 8 + 4 * hi) = wv; } }
                else { const int chn = u - NU_P; const float dec = sWk[64], gn = sWk[65];
#pragma unroll
                    for (int r = 0; r < 16; ++r) { const size_t ci = (size_t)chn * 16384 + (db * 32 + crow(r, hi)) * 128 + eb * 32 + r32; P.out[O_CS + ci] = dec * P.in[4][ci] + gn * acc[r]; } } }
            if (tid < 128) { float sm = 0.f;
#pragma unroll
                for (int q = 0; q < 8; ++q) if (q * 8 < L) { const u32x4 r = *(const LAS u32x4*)(wkT + tix(tid, q * 8)); sm += (bflo(r.x) + bfhi(r.x)) + (bflo(r.y) + bfhi(r.y)) + (bflo(r.z) + bfhi(r.z)) + (bflo(r.w) + bfhi(r.w)); }
                if (sb < 0) DN[(size_t)u * 128 + tid] = sm; else { const int chn = u - NU_P; P.out[O_NS + chn * 128 + tid] = sWk[64] * P.in[5][chn * 128 + tid] + sWk[65] * sm; } }
        }
        __syncthreads();
    }
#undef M1_LOAD
}
__device__ __forceinline__ void mlstm_m2(const Ptrs& P, LAS unsigned char* lds, int tid, int wave, int lane, int G_) {
    unsigned char* ws = P.ws; float* out = P.out;
    bf16* DC = (bf16*)(ws + WS_DC); float* DN = (float*)(ws + WS_DN); const float* SC = (const float*)(ws + WS_SC); float* SM = (float*)(ws + WS_SC + 65536);
    LAS float* sDec = (LAS float*)lds;
    LAS float* sGn = (LAS float*)(lds + 8192);
    LAS float* sM = (LAS float*)(lds + 16384);
    {
        const int b = wave >> 2, h = wave & 3; float bL[4], Gm[4];
#pragma unroll
        for (int k = 0; k < 4; ++k) { const int u = b * 1024 + (4 * lane + k) * 4 + h; bL[k] = SC[2 * u]; Gm[k] = SC[2 * u + 1]; }
        float A = bL[0], D = Gm[0] + bL[0];
#pragma unroll
        for (int k = 1; k < 4; ++k) { D = fmaxf(D + bL[k], Gm[k] + bL[k]); A += bL[k]; }
#pragma unroll
        for (int o = 1; o < 64; o <<= 1) { const float Ap = __shfl_up(A, o), Dp = __shfl_up(D, o); if (lane >= o) { D = fmaxf(Dp + A, D); A = Ap + A; } }
        const float Ae = __shfl_up(A, 1), De = __shfl_up(D, 1);
        float m = lane ? fmaxf(Ae, De) : 0.f;
#pragma unroll
        for (int k = 0; k < 4; ++k) { const int c = 4 * lane + k; const float Mx = fmaxf(m, Gm[k]); sM[wave * 257 + c] = m; sDec[wave * 256 + c] = __expf(m - Mx); sGn[wave * 256 + c] = __expf(Gm[k] - Mx); m = bL[k] + Mx; }
        if (lane == 63) sM[wave * 257 + 256] = m;
    }
    __syncthreads();
    if (wave == 0) {
        for (int v = blockIdx.x * 64 + lane; v < 16384; v += G_ * 64) { const int ch = v >> 11, off = (v & 2047) * 8, b = ch >> 2, h = ch & 3;
            bf16* p = DC + (size_t)(b * 1024 + h) * 16384 + off; float carry[8];
#pragma unroll
            for (int j = 0; j < 8; ++j) carry[j] = 0.f;
            for (int c = 0; c < 256; c += 16) { u32x4 x[16];
#pragma unroll
                for (int k = 0; k < 16; ++k) x[k] = *(const u32x4*)(p + (size_t)(c + k) * 65536);
#pragma unroll
                for (int k = 0; k < 16; ++k) { const float dec = sDec[ch * 256 + c + k], gn = sGn[ch * 256 + c + k];
                    u32x4 o; o.x = pk2(carry[0], carry[1]); o.y = pk2(carry[2], carry[3]); o.z = pk2(carry[4], carry[5]); o.w = pk2(carry[6], carry[7]);
                    *(u32x4*)(p + (size_t)(c + k) * 65536) = o;
                    carry[0] = dec * carry[0] + gn * bflo(x[k].x); carry[1] = dec * carry[1] + gn * bfhi(x[k].x); carry[2] = dec * carry[2] + gn * bflo(x[k].y); carry[3] = dec * carry[3] + gn * bfhi(x[k].y);
                    carry[4] = dec * carry[4] + gn * bflo(x[k].z); carry[5] = dec * carry[5] + gn * bfhi(x[k].z); carry[6] = dec * carry[6] + gn * bflo(x[k].w); carry[7] = dec * carry[7] + gn * bfhi(x[k].w); } }
            const int pi = off >> 3, ee = (pi >> 9) * 32 + (pi & 31), dd = ((pi >> 6) & 7) * 16 + ((pi >> 5) & 1) * 8;
#pragma unroll
            for (int j = 0; j < 8; ++j) out[O_CP + (size_t)ch * 16384 + (dd + j) * 128 + ee] = carry[j]; }
    } else if (wave == 1) {
        for (int i = blockIdx.x * 64 + lane; i < 1024; i += G_ * 64) { const int ch = i >> 7, d = i & 127, b = ch >> 2, h = ch & 3; float carry = 0.f;
            float* pn = DN + (size_t)(b * 1024 + h) * 128 + d;
            for (int c = 0; c < 256; c += 16) { float x[16];
#pragma unroll
                for (int k = 0; k < 16; ++k) x[k] = pn[(size_t)(c + k) * 512];
#pragma unroll
                for (int k = 0; k < 16; ++k) { pn[(size_t)(c + k) * 512] = carry; carry = sDec[ch * 256 + c + k] * carry + sGn[ch * 256 + c + k] * x[k]; } }
            out[O_NP + ch * 128 + d] = carry; }
    } else if (blockIdx.x == 0) {
        for (int i = tid - 128; i < NU_P; i += NTHR - 128) { const int b = i >> 10, c = (i >> 2) & 255, h = i & 3; SM[i] = sM[(b * 4 + h) * 257 + c]; }
        if (tid >= 128 && tid < 136) out[O_MP + tid - 128] = sM[(tid - 128) * 257 + 256];
    }
}
__device__ __forceinline__ void mlstm_m3_gates(const Ptrs& P, LAS unsigned char* lds, int wave, int lane, int G_) {
    unsigned char* ws = P.ws; const float* G = (const float*)(ws + WS_G); const float* DN = (const float*)(ws + WS_DN); const float* SM = (const float*)(ws + WS_SC + 65536);
    const int nun = (NU - (int)blockIdx.x + G_ - 1) / G_;
    for (int k = wave; k < nun; k += NWAVES) { const int u = blockIdx.x + k * G_; int row0, L, h, c, sb; unit_decode(u, row0, L, h, c, sb);
        LAS float* gtab = (LAS float*)(lds + ML_GATE) + (k & 15) * 384;
        const float* np_ = (sb < 0) ? DN + (size_t)u * 128 : P.in[5] + (size_t)(u - NU_P) * 128; const float n0 = np_[lane], n1 = np_[64 + lane];
        float b, g, bL, Gm; unit_gates(G, row0, L, h, lane, b, g, bL, Gm); const float mc = (sb < 0) ? SM[u] : P.in[6][u - NU_P];
        float Mx = g;
#pragma unroll
        for (int o = 1; o < 64; o <<= 1) { const float x = __shfl_up(Mx, o); if (lane >= o) Mx = fmaxf(Mx, x); }
        const float Mt = fmaxf(mc, Mx);
        gtab[lane] = g; gtab[64 + lane] = Mt; gtab[128 + lane] = __expf(mc - Mt); gtab[192 + lane] = __expf(-(b + Mt)); gtab[256 + lane] = n0; gtab[320 + lane] = n1; }
}
__device__ __forceinline__ void mlstm_m3_unit(const Ptrs& P, LAS unsigned char* lds, int u, int kslot, int tid, int wave, int lane) {
    unsigned char* ws = P.ws;
    const bf16* Z = (const bf16*)(ws + WS_BIG); const float* G = (const float*)(ws + WS_G);
    const bf16* QC = (const bf16*)(ws + WS_QC); const bf16* KC = (const bf16*)(ws + WS_KC); const bf16* DC = (const bf16*)(ws + WS_DC); const float* DN = (const float*)(ws + WS_DN);
    const float* SM = (const float*)(ws + WS_SC + 65536); bf16* MIX = (bf16*)(ws + WS_H);
    LAS bf16* vT = (LAS bf16*)(lds + ML_VT); LAS float* F = (LAS float*)(lds + ML_F);
    const LAS float* gtab = (const LAS float*)(lds + ML_GATE) + (kslot & 15) * 384;
    const LAS float* sg = gtab, *sMt = gtab + 64, *siw = gtab + 128, *semt = gtab + 192, *sN = gtab + 256; LAS float* sSS = F + 384;
    int row0, L, h, c, sb; unit_decode(u, row0, L, h, c, sb);
    const int r32 = lane & 31, hi = lane >> 5, eb = wave & 3, tb = wave >> 2; const bool active = tb * 32 < L; const int t = tb * 32 + r32;
    const int vg = tid & 15; const int sv0 = tid >> 4; u32x4 vr[2];
#pragma unroll
    for (int i = 0; i < 2; ++i) if (sv0 + 32 * i < L) vr[i] = *(const u32x4*)(Z + (size_t)(row0 + sv0 + 32 * i) * NZ + 2048 + h * 128 + 8 * vg);
    bf16x8 qf[8], Kf[2][8], Cf[8]; u32x2 og[4]; f32x4 gnm[4];
    if (active) {
#pragma unroll
        for (int ds = 0; ds < 8; ++ds) qf[ds] = *(const bf16x8*)(QC + (((size_t)(((row0 >> 5) + tb) * 4 + h) * 8 + ds) * 64 + lane) * 8);
#pragma unroll
        for (int ds = 0; ds < 8; ++ds) {
            if (sb < 0) Cf[ds] = *(const bf16x8*)(DC + ((((size_t)u * 4 + eb) * 8 + ds) * 64 + lane) * 8);
            else { const float* cp = P.in[4] + (size_t)(u - NU_P) * 16384 + (size_t)(ds * 16 + hi * 8) * 128 + eb * 32 + r32; float t8[8];
#pragma unroll
                for (int j = 0; j < 8; ++j) t8[j] = cp[j * 128];
                Cf[ds] = pack8f(t8); } }
#pragma unroll
        for (int sbk = 0; sbk < 2; ++sbk) if (sbk <= tb)
#pragma unroll
            for (int ds = 0; ds < 8; ++ds) Kf[sbk][ds] = *(const bf16x8*)(KC + (((size_t)(((row0 >> 5) + sbk) * 4 + h) * 8 + ds) * 64 + lane) * 8);
#pragma unroll
        for (int a = 0; a < 4; ++a) { og[a] = *(const u32x2*)(Z + (size_t)(row0 + t) * NZ + 2560 + h * 128 + eb * 32 + 8 * a + 4 * hi); gnm[a] = *(const f32x4*)(P.in[18] + h * 128 + eb * 32 + 4 * hi + 8 * a); }
    }
#pragma unroll
    for (int i = 0; i < 2; ++i) if (sv0 + 32 * i < L) { const u32x4 r = vr[i]; LAS bf16* d = vT + tix(8 * vg, sv0 + 32 * i);
        d[0] = (bf16)(r.x & 0xffff); d[VT_LD] = (bf16)(r.x >> 16); d[2 * VT_LD] = (bf16)(r.y & 0xffff); d[3 * VT_LD] = (bf16)(r.y >> 16);
        d[4 * VT_LD] = (bf16)(r.z & 0xffff); d[5 * VT_LD] = (bf16)(r.z >> 16); d[6 * VT_LD] = (bf16)(r.w & 0xffff); d[7 * VT_LD] = (bf16)(r.w >> 16); }
    __syncthreads();
    float val[16];
    if (active) {
        f32x16 acc;
#pragma unroll
        for (int r = 0; r < 16; ++r) acc[r] = 0.f;
#pragma unroll
        for (int ds = 0; ds < 8; ++ds) acc = MFMA32(Cf[ds], qf[ds], acc);
        const float iw = siw[t], Mt = sMt[t];
#pragma unroll
        for (int r = 0; r < 16; ++r) acc[r] *= iw;
        float qn = 0.f;
#pragma unroll
        for (int ds = 0; ds < 8; ++ds)
#pragma unroll
            for (int j = 0; j < 8; ++j) qn += bf2f((bf16)qf[ds][j]) * sN[ds * 16 + hi * 8 + j];
        qn = xh_sum(qn);
        float den = iw * qn;
#pragma unroll
        for (int sbk = 0; sbk < 2; ++sbk) if (sbk <= tb) {
            f32x16 st;
#pragma unroll
            for (int r = 0; r < 16; ++r) st[r] = 0.f;
#pragma unroll
            for (int ds = 0; ds < 8; ++ds) st = MFMA32(Kf[sbk][ds], qf[ds], st);
            float p[16]; float ps = 0.f;
#pragma unroll
            for (int r = 0; r < 16; ++r) { const int s_ = sbk * 32 + crow(r, hi); const float w = __expf(fminf(sg[s_] - Mt, 0.f)); p[r] = (s_ <= t) ? st[r] * w : 0.f; ps += p[r]; }
            ps = xh_sum(ps); den += ps;
            const bf16x8 p0 = pack8f(p), p1 = pack8f(p + 8);
            const int vrow = eb * 32 + r32;
            { const u32x2 lo = *(const LAS u32x2*)(vT + tix(vrow, sbk * 32 + 4 * hi)), hh = *(const LAS u32x2*)(vT + tix(vrow, sbk * 32 + 8 + 4 * hi)); u32x4 a; a.x = lo.x; a.y = lo.y; a.z = hh.x; a.w = hh.y; acc = MFMA32(__builtin_bit_cast(bf16x8, a), p0, acc); }
            { const u32x2 lo = *(const LAS u32x2*)(vT + tix(vrow, sbk * 32 + 16 + 4 * hi)), hh = *(const LAS u32x2*)(vT + tix(vrow, sbk * 32 + 24 + 4 * hi)); u32x4 a; a.x = lo.x; a.y = lo.y; a.z = hh.x; a.w = hh.y; acc = MFMA32(__builtin_bit_cast(bf16x8, a), p1, acc); }
        }
        const float inv = 1.0f / fmaxf(fabsf(den), semt[t]);
        float ss = 0.f;
#pragma unroll
        for (int a = 0; a < 4; ++a) {
            val[4 * a] = acc[4 * a] * inv * bflo(og[a].x); val[4 * a + 1] = acc[4 * a + 1] * inv * bfhi(og[a].x); val[4 * a + 2] = acc[4 * a + 2] * inv * bflo(og[a].y); val[4 * a + 3] = acc[4 * a + 3] * inv * bfhi(og[a].y);
            ss += (val[4 * a] * val[4 * a] + val[4 * a + 1] * val[4 * a + 1]) + (val[4 * a + 2] * val[4 * a + 2] + val[4 * a + 3] * val[4 * a + 3]); }
        ss = xh_sum(ss);
        if (hi == 0) sSS[eb * 64 + t] = ss;
    }
    __syncthreads();
    if (active) {
        const float tot = (sSS[t] + sSS[64 + t]) + (sSS[128 + t] + sSS[192 + t]); const float rstd = 1.0f / sqrtf(tot * (1.0f / 128.0f) + 1e-6f);
        bf16* op = MIX + (size_t)(row0 + t) * DM + 512 + h * 128 + eb * 32 + 4 * hi;
#pragma unroll
        for (int a = 0; a < 4; ++a) { const f32x4 gn = gnm[a]; u32x2 w; w.x = pk2(val[4 * a] * rstd * gn.x, val[4 * a + 1] * rstd * gn.y); w.y = pk2(val[4 * a + 2] * rstd * gn.z, val[4 * a + 3] * rstd * gn.w);
            *(u32x2*)(op + 8 * a) = w; }
    }
}

#define XB_TMO      128
#define XB_XCNT(j)  (256  + 64 * (j))
#define XB_XSUB(j)  (1280 + 64 * (j))
#define XB_XGEN(j)  (2304 + 64 * (j))
#define XB_TOP      3328
#define XB_TOPGEN   3392
#define XCD_BAR_WORDS 3456
#define XB_SPIN_CAP (1u << 18)

__device__ __forceinline__ unsigned xb_ld(unsigned* p)              { return __hip_atomic_load(p, __ATOMIC_RELAXED, __HIP_MEMORY_SCOPE_AGENT); }
__device__ __forceinline__ unsigned xb_add(unsigned* p, unsigned v) { return __hip_atomic_fetch_add(p, v, __ATOMIC_RELAXED, __HIP_MEMORY_SCOPE_AGENT); }
__device__ __forceinline__ unsigned xb_xcc_id() { return (unsigned)__builtin_amdgcn_s_getreg((3 << 11) | 20) & 0xFu; }
#define XB_SPIN(cond, bar) do { unsigned _sp = 0; while (cond) { __builtin_amdgcn_s_sleep(1); \
    if ((++_sp & 255u) == 0u) { if (xb_ld(&(bar)[XB_TMO])) break; if (_sp > XB_SPIN_CAP) { atomicAdd(&(bar)[XB_TMO], 1u); break; } } } } while (0)

struct XcdBarrier {
    unsigned* bar; unsigned x;
    volatile LAS unsigned* st;
};

__device__ __forceinline__ XcdBarrier xcd_barrier_post(unsigned* bar, volatile LAS unsigned* st) {
    XcdBarrier b; b.bar = bar; b.x = xb_xcc_id(); b.st = st;
    if (threadIdx.x == 0) (void)xb_add(&bar[XB_XCNT(b.x)], 1u);
    return b;
}
__device__ __forceinline__ void xcd_barrier_complete(unsigned* bar, unsigned x, unsigned& nloc, unsigned& nx) {
    const unsigned G = gridDim.x * gridDim.y * gridDim.z;
    unsigned sum, cnt, mine, sp = 0u;
    for (;;) {
        sum = 0u; cnt = 0u; mine = 0u;
#pragma unroll
        for (unsigned j = 0; j < 16; ++j) { const unsigned c = xb_ld(&bar[XB_XCNT(j)]); sum += c; cnt += (c > 0u) ? 1u : 0u; mine = (j == x) ? c : mine; }
        if (sum == G) break;
        __builtin_amdgcn_s_sleep(1);
        if ((++sp & 255u) == 0u) { if (xb_ld(&bar[XB_TMO])) break; if (sp > XB_SPIN_CAP) { atomicAdd(&bar[XB_TMO], 1u); break; } }
    }
    nloc = mine > 0u ? mine : 1u; nx = cnt > 0u ? cnt : 1u;
}

__device__ __forceinline__ void xcd_barrier(const XcdBarrier& b) {
    asm volatile("s_waitcnt vmcnt(0)" ::: "memory");
    __syncthreads();
    if (threadIdx.x == 0) {
        unsigned* bar = b.bar;
        __builtin_amdgcn_s_waitcnt(0);
        unsigned nloc = b.st[0], nx = b.st[1];
        if (nloc == 0u) { xcd_barrier_complete(bar, b.x, nloc, nx); b.st[0] = nloc; b.st[1] = nx; }
        const unsigned old = xb_add(&bar[XB_XSUB(b.x)], 1u);
        const unsigned gen = old / nloc;
        if (old + 1u == (gen + 1u) * nloc) {
            __builtin_amdgcn_fence(__ATOMIC_RELEASE, "agent");
            asm volatile("s_waitcnt vmcnt(0)" ::: "memory");
            const unsigned og = xb_add(&bar[XB_TOP], 1u);
            const unsigned tg = og / nx;
            if (og + 1u == (tg + 1u) * nx) xb_add(&bar[XB_TOPGEN], 1u);
            else XB_SPIN(xb_ld(&bar[XB_TOPGEN]) == tg, bar);
            __builtin_amdgcn_fence(__ATOMIC_ACQUIRE, "agent");
            xb_add(&bar[XB_XGEN(b.x)], 1u);
            asm volatile("s_waitcnt vmcnt(0)" ::: "memory");
        } else {
            XB_SPIN(xb_ld(&bar[XB_XGEN(b.x)]) == gen, bar);
            __builtin_amdgcn_fence(__ATOMIC_ACQUIRE, "agent");
            asm volatile("s_waitcnt vmcnt(0)" ::: "memory");
        }
    }
    __syncthreads();
}

__global__ void __launch_bounds__(NTHR, 2) fwd_kernel(Ptrs P) {
    extern __shared__ __attribute__((aligned(16))) unsigned char lds_raw[];
    LAS unsigned char* lds = (LAS unsigned char*)lds_raw;
    const int tid = threadIdx.x, lane = tid & 63, wave = __builtin_amdgcn_readfirstlane(tid >> 6);
    const int G_ = gridDim.x, gw = blockIdx.x * NWAVES + wave, NGW = G_ * NWAVES;
    unsigned char* ws = P.ws; float* out = P.out;
    bf16* XS = (bf16*)(out + O_Y);
    float* XSAMP = (float*)(ws + WS_QC + 44 * MiB);
    bf16* H = (bf16*)(ws + WS_H); bf16* ACT = (bf16*)(ws + WS_BIG); bf16* Z = (bf16*)(ws + WS_BIG); bf16* VT = (bf16*)(ws + WS_VT); float* Gt = (float*)(ws + WS_G);
    const int lo = P.ph_lo, hi_ = P.ph_hi;
    volatile LAS unsigned* bst = (volatile LAS unsigned*)(lds + LDS_BYTES - 64);
    if (tid < 16) bst[tid] = 0u;
    __syncthreads();
    XcdBarrier bar; bar.bar = (unsigned*)(ws + WS_CTL) + 4096; bar.x = 0; bar.st = nullptr;
    if (P.coop) bar = xcd_barrier_post((unsigned*)(ws + WS_CTL) + 4096, bst);
#define IN(k) (lo <= (k) && (k) < hi_)
#define SEAM(k) do { if (IN(k) && IN((k) + 1)) { if (P.coop == 2) cg::this_grid().sync(); else xcd_barrier(bar); } } while (0)

    if (IN(0)) { p0_weights(P, (LAS float*)(lds + wave * 16384), gw, NGW, lane, 0, 10752 - 4224, 4224, 8448);
        for (int i = blockIdx.x * NTHR + tid; i < TS * DM / 4; i += G_ * NTHR) { const f32x4 xv = ((const f32x4*)P.in[1])[i]; u32x2 w; w.x = pk2(xv.x, xv.y); w.y = pk2(xv.z, xv.w); ((u32x2*)(XS + (size_t)TP * DM))[i] = w; } rms_rows<0>(P.in[0], P.in[1], P.in[8], H, nullptr, nullptr, nullptr, nullptr, gw, NGW, lane, nullptr, 0, nullptr); }
    SEAM(0);
    if (IN(1)) { pg8::Gemm g{H, (const bf16*)(ws + WS_W13A), T, 2 * FF, DM}; pg8::StaticOrder S; S.init(T, 2 * FF, G_, (int)blockIdx.x, DM); pg8::EpiSwiGLU E{ACT, FF};
        pg8::gemm_phase<pg8::EpiSwiGLU, pg8::StaticOrder, true, true>(lds, g, S, E); }
    SEAM(1);
    if (IN(2)) { pg8::Gemm g{ACT, (const bf16*)(ws + WS_W2A), T, DM, FF}; pg8::TailOrder S; S.init(TP, TS, DM, G_, (int)blockIdx.x, FF, 11); pg8::EpiResIn E{P.in[0], P.in[1], XS, (float*)(ws + WS_QC)};
        pg8::gemm_phase<pg8::EpiResIn, pg8::TailOrder, true, true, true>(lds, g, S, E); }
    SEAM(2);
    if (IN(3)) {
        LAS float* gwl = (LAS float*)lds; const float* win = P.in[13];
        for (int i = tid; i < 8192; i += NTHR) { const int k = i >> 3, q = i & 7; const int l = (k & 255) >> 2, ii = k & 3, j = k >> 8; gwl[((j * 4 + ii) * 64 + l) * 8 + q] = win[(size_t)k * 3592 + 3584 + q]; }
        __syncthreads();
        rms_rows_b<1>(XS, P.in[12], H, gwl, P.in[16], Gt, gw, NGW, lane, (const float*)(ws + WS_QC), 11, nullptr);
        __syncthreads();
    }
    SEAM(3);
    if (IN(4)) {
        { pg8::Gemm g{H, (const bf16*)(ws + WS_WIN), T, NZ, DM}; pg8::StaticOrder S; S.init(T, NZ, G_, (int)blockIdx.x, DM); pg8::EpiZ E{Z, out + O_KP, out + O_KS, (bf16*)(ws + WS_KF)};
          pg8::gemm_phase<pg8::EpiZ, pg8::StaticOrder, true, true>(lds, g, S, E); }
        { pg8::Gemm g{(const bf16*)(ws + WS_WV), H, 512, T, DM}; pg8::StaticOrder S; S.init(512, T, G_, (int)((blockIdx.x + G_ - 48) % G_), DM); pg8::EpiVT E{VT, out + O_VP, out + O_VS};
          pg8::gemm_phase<pg8::EpiVT, pg8::StaticOrder, true, true>(lds, g, S, E); }
    }
    SEAM(4);
    if (IN(5)) {
        LAS float* rb = (LAS float*)lds; const float* rbg = P.in[17];
        for (int i = tid; i < 8 * 257; i += NTHR) rb[i] = rbg[i] * 1.4426950408889634f;
        __syncthreads();
        if (G_ == 256) {
            const int vcu = ((int)blockIdx.x & 7) * 32 + ((int)blockIdx.x >> 3); const int h = wave;
            const int b = vcu >> 7;
            for (int cc = 0; cc < 2; ++cc) { const int c = (vcu & 127) * 2 + cc; const int c0 = c > 8 ? c - 8 : 0;
                attn_unit<2>(Z, (const bf16*)(ws + WS_KF), VT, nullptr, nullptr, H, rb + h * 257, h, b * 16384 + c * 64, b * 16384 + c0 * 64, 0, (c - c0 + 1) * 2, 0, c * 64, c0 * 64, lane); }
        } else
        for (int u = gw + 256; u < 256 + 4096; u += NGW) {
            { const int v = u - 256, h = v & 7, c = (v >> 3) & 255, b = v >> 11; const int c0 = c > 8 ? c - 8 : 0;
                attn_unit<2>(Z, (const bf16*)(ws + WS_KF), VT, nullptr, nullptr, H, rb + h * 257, h, b * 16384 + c * 64, b * 16384 + c0 * 64, 0, (c - c0 + 1) * 2, 0, c * 64, c0 * 64, lane); }
        }
        __syncthreads();
    }
    if (IN(6)) {
        mlstm_m1_phase(P, lds, tid, wave, lane, G_);
        for (int i = blockIdx.x * NTHR + tid; i < 34 * 3 * 1024; i += G_ * NTHR) { const int ch = i & 1023, j = (i >> 10) % 3, b = i / 3072;
            if (b < 2) out[O_CVP + (size_t)(b * 3 + j) * 1024 + ch] = bf2f(Z[(size_t)(b * 16384 + 16381 + j) * NZ + 1024 + ch]);
            else out[O_CVS + (size_t)((b - 2) * 3 + j) * 1024 + ch] = bf2f(Z[(size_t)(TP + (b - 2) * 32 + 29 + j) * NZ + 1024 + ch]); }
    }
    SEAM(6);
    if (IN(7)) {
        LAS float* rb = (LAS float*)(lds + 32768); const float* rbg = P.in[17];
        for (int i = tid; i < 8 * 257; i += NTHR) rb[i] = rbg[i] * 1.4426950408889634f;
        mlstm_m2(P, lds, tid, wave, lane, G_);
        if (wave >= 3) p0_weights(P, (LAS float*)(lds + 49152 + (wave - 3) * 8448), (int)blockIdx.x * 5 + (wave - 3), G_ * 5, lane, 4224, 8448, 1 << 30, 1 << 30);
        if (wave >= 2) for (int u = blockIdx.x + G_ * (wave - 2); u < 256; u += G_ * 6) { const int b = u >> 3, h = u & 7;
            attn_unit<1>(Z, (const bf16*)(ws + WS_KF), VT, P.in[2], P.in[3], H, rb + h * 257, h, TP + b * 32, TP + b * 32, 16, 1, b, 4096, 3584, lane); }
    }
    SEAM(7);
    if (IN(8)) { mlstm_m3_gates(P, lds, wave, lane, G_); __syncthreads(); int kslot = 0; for (int u = blockIdx.x; u < NU; u += G_, ++kslot) mlstm_m3_unit(P, lds, u, kslot, tid, wave, lane); }
    SEAM(8);
    if (IN(9)) { pg8::Gemm g{H, (const bf16*)(ws + WS_WOUT), T, DM, DM}; pg8::TailOrder S; S.init(TP, TS, DM, G_, (int)blockIdx.x, DM, 4); pg8::EpiResB<2> E{XS, XS, (float*)(ws + WS_QC)};
        pg8::gemm_phase<pg8::EpiResB<2>, pg8::TailOrder, true, true>(lds, g, S, E); }
    SEAM(9);
    if (IN(10)) rms_rows_b<0>(XS, P.in[20], H, nullptr, nullptr, nullptr, gw, NGW, lane, (const float*)(ws + WS_QC), 4, XSAMP);
    SEAM(10);
    if (IN(11)) { pg8::Gemm g{H, (const bf16*)(ws + WS_W13B), T, 2 * FF, DM}; pg8::StaticOrder S; S.init(T, 2 * FF, G_, (int)blockIdx.x, DM); pg8::EpiSwiGLU E{ACT, FF};
        pg8::gemm_phase<pg8::EpiSwiGLU, pg8::StaticOrder, true, true>(lds, g, S, E); }
    SEAM(11);
    if (IN(12)) { pg8::Gemm g{ACT, (const bf16*)(ws + WS_W2B), T, DM, FF}; pg8::TailOrder S; S.init(TP, TS, DM, G_, (int)blockIdx.x, FF, 11); pg8::EpiResB<1> E{XS, H, (float*)(ws + WS_QC)};
        pg8::gemm_phase<pg8::EpiResB<1>, pg8::TailOrder, true, true, true>(lds, g, S, E); }
    SEAM(12);
    if (IN(13)) {
        const bf16* X3 = H; const float* slab = (const float*)(ws + WS_QC); float* Y = out + O_Y;
        f32x4 g[4];
#pragma unroll
        for (int j = 0; j < 4; ++j) g[j] = ((const f32x4*)P.in[24])[lane + 64 * j];
        u32x2 nb[4]; f32x4 nf[4];
#define FN_LOAD(mm) do { const int mm_ = (mm); if (mm_ < TP) { _Pragma("unroll") for (int j = 0; j < 4; ++j) nb[j] = __builtin_nontemporal_load(&((const u32x2*)(X3 + (size_t)mm_ * DM))[lane + 64 * j]); } \
            else if (mm_ < T) { _Pragma("unroll") for (int j = 0; j < 4; ++j) nf[j] = ((const f32x4*)(XSAMP + (size_t)(mm_ - TP) * DM))[lane + 64 * j]; } } while (0)
        FN_LOAD(gw);
        for (int m = gw; m < T; m += NGW) { f32x4 v[4];
            if (m < TP) {
#pragma unroll
                for (int j = 0; j < 4; ++j) { v[j].x = bflo(nb[j].x); v[j].y = bfhi(nb[j].x); v[j].z = bflo(nb[j].y); v[j].w = bfhi(nb[j].y); } }
            else {
#pragma unroll
                for (int j = 0; j < 4; ++j) v[j] = nf[j]; }
            FN_LOAD(m + NGW);
            if (m >= TP) for (int kp = 0; kp < 11; ++kp) { const f32x4* sp = (const f32x4*)(slab + ((size_t)kp * 1024 + (m - TP)) * DM);
#pragma unroll
                for (int j = 0; j < 4; ++j) v[j] += sp[lane + 64 * j]; }
            float sq = 0.f;
#pragma unroll
            for (int j = 0; j < 4; ++j) sq += (v[j].x * v[j].x + v[j].y * v[j].y) + (v[j].z * v[j].z + v[j].w * v[j].w);
            sq = wave_sum(sq); const float rstd = 1.0f / sqrtf(sq * (1.0f / DM) + 1e-6f);
#pragma unroll
            for (int j = 0; j < 4; ++j) __builtin_nontemporal_store(v[j] * rstd * g[j], &((f32x4*)(Y + (size_t)m * DM))[lane + 64 * j]); }
#undef FN_LOAD
    }
#undef IN
#undef SEAM
}

#ifndef PROBE_PH
#define PROBE_PH -1
#define PROBE_REP 3
#endif
#ifndef N_LAUNCH_MODE
#define N_LAUNCH_MODE 0
#endif
extern "C" void kernel_launch(void* const* d_in, const int* in_sizes, int n_in, void* d_out, int out_size, void* d_ws, size_t ws_size, hipStream_t stream) {
    static int grid = 0;
    if (grid == 0) {
        if (n_in != 25 || out_size != (int)O_END || ws_size < WS_END) { fprintf(stderr, "kernel_launch: unexpected shapes n_in %d out %d ws %zu\n", n_in, out_size, ws_size); grid = -1; return; }
        int dev = 0, cus = 0, per_cu = 0;
        hipGetDevice(&dev); hipDeviceGetAttribute(&cus, hipDeviceAttributeMultiprocessorCount, dev);
        if (hipFuncSetAttribute((const void*)fwd_kernel, hipFuncAttributeMaxDynamicSharedMemorySize, LDS_BYTES) != hipSuccess) { fprintf(stderr, "kernel_launch: hipFuncSetAttribute failed\n"); grid = -1; return; }
        if (hipOccupancyMaxActiveBlocksPerMultiprocessor(&per_cu, (const void*)fwd_kernel, NTHR, LDS_BYTES) != hipSuccess || per_cu < 1) { fprintf(stderr, "kernel_launch: occupancy query says %d\n", per_cu); per_cu = 1; }
        (void)hipGetLastError();
        grid = cus * 1;
    }
    if (grid < 0) return;
    Ptrs p{};
    for (int i = 0; i < 25; ++i) p.in[i] = (const float*)d_in[i];
    p.out = (float*)d_out; p.ws = (unsigned char*)d_ws;
#if N_LAUNCH_MODE == 1
    for (int ph = 0; ph < 14; ++ph) { const int nrep = (ph == PROBE_PH) ? PROBE_REP : 1;
        for (int r = 0; r < nrep; ++r) { p.ph_lo = ph; p.ph_hi = ph + 1; p.coop = 0; hipLaunchKernelGGL(fwd_kernel, dim3(grid), dim3(NTHR), LDS_BYTES, stream, p); } }
#else
    if (hipMemsetAsync((char*)d_ws + WS_CTL, 0, CTL_BYTES, stream) != hipSuccess) { fprintf(stderr, "kernel_launch: memset failed\n"); return; }
    p.ph_lo = 0; p.ph_hi = 14; p.coop = 1;
    void* args[] = {&p};
    hipError_t e = hipLaunchCooperativeKernel((const void*)fwd_kernel, dim3(grid), dim3(NTHR), args, LDS_BYTES, stream);
    if (e != hipSuccess) fprintf(stderr, "kernel_launch: cooperative launch failed: %s (grid %d)\n", hipGetErrorString(e), grid);
#endif
}
```

```cpp
#include <hip/hip_runtime.h>
#include <hip/hip_cooperative_groups.h>
#include <cstdio>
#include <cstdint>
namespace cg = cooperative_groups;
namespace pg8 {
#define PG8_LAS __attribute__((address_space(3)))
typedef unsigned short bf16_t;
typedef short bf16x8 __attribute__((ext_vector_type(8)));
typedef float f32x4 __attribute__((ext_vector_type(4)));
typedef unsigned u32x4 __attribute__((ext_vector_type(4)));
typedef unsigned u32x2 __attribute__((ext_vector_type(2)));
constexpr int BM = 256, BK = 64, HALF = 128, HTB = HALF * BK * 2  , STAGE_BYTES = 8 * HTB, NXCD = 8, WGM = 8;

__host__ __device__ __forceinline__ int lds_byte(int r, int c) { const int st = (r >> 4) * 2 + (c >> 5), rr = r & 15, cc = c & 31, ob = rr * 64 + cc * 2; return st * 1024 + (ob ^ (((ob >> 9) & 1) << 5)); }
__host__ __device__ __forceinline__ void stage_rc(int b, int& R, int& C) { const int st = b / 1024, sb = b % 1024, swz = sb ^ (((sb >> 9) & 1) << 5); R = (st >> 1) * 16 + swz / 64; C = (st & 1) * 32 + (swz % 64) / 2; }
__host__ __device__ __forceinline__ int perm32(int rho) { const int n = rho >> 4, i = rho & 15; return 8 * (i >> 2) + 4 * n + (i & 3); }

struct Unit { int pm, pn, k0, nt, kp; };
struct Gemm { const bf16_t* A; const bf16_t* Bt; int M, N, K; };

struct StaticOrder {
    int nM, nN, nwg, G, c, ntK;
    __host__ __device__ void init(int M, int N, int G_, int c_, int K_) { nM = M / BM; nN = N / BM; nwg = nM * nN; G = G_; c = c_; ntK = K_ / BK; }
    __host__ __device__ bool next(int i, Unit& u) const {
        const long L = (long)i * G + c; if (L >= nwg) return false;
        int wgid = (int)L; { const int q = nwg / NXCD, r = nwg % NXCD, xcd = wgid % NXCD, off = wgid / NXCD; wgid = (xcd < r ? xcd * (q + 1) : r * (q + 1) + (xcd - r) * q) + off; }
        const int nig = WGM * nN, gid = wgid / nig, fm = gid * WGM, gsz = (nM - fm) < WGM ? (nM - fm) : WGM;
        u.pm = fm + ((wgid % nig) % gsz); u.pn = (wgid % nig) / gsz; u.k0 = 0; u.nt = ntK; u.kp = -1; return true;
    }
    __device__ __forceinline__ void a_ready(const Unit&) const {}
    __device__ __forceinline__ void done(const Unit&) const {}
};

struct TailOrder {
    StaticOrder so; int nTailM, nsplit, ntPiece, nMain, G, c;
    __host__ __device__ void init(int Mmain, int Mtail, int N, int G_, int c_, int K_, int nsplit_) { so.init(Mmain, N, G_, c_, K_); nMain = so.nwg; nTailM = Mtail / BM; nsplit = nsplit_; ntPiece = (K_ / BK) / nsplit_; G = G_; c = c_; }
    __host__ __device__ bool next(int i, Unit& u) const {
        const long L = (long)i * G + c;
        if (L < nMain) return so.next(i, u);
        const int sidx = (int)(L - nMain); if (sidx >= nTailM * so.nN * nsplit) return false;
        const int tile = sidx / nsplit, kp = sidx % nsplit; u.pm = so.nM + tile / so.nN; u.pn = tile % so.nN; u.k0 = kp * ntPiece * BK; u.nt = ntPiece; u.kp = kp; return true;
    }
    __device__ __forceinline__ void a_ready(const Unit&) const {}
    __device__ __forceinline__ void done(const Unit&) const {}
};
__device__ __forceinline__ unsigned cvt_pk_bf16(float lo, float hi) { unsigned r; asm volatile("v_cvt_pk_bf16_f32 %0, %1, %2" : "=v"(r) : "v"(lo), "v"(hi)); return r; }
typedef float f32x2 __attribute__((ext_vector_type(2)));
__device__ __forceinline__ float silu_f(float x) { return x * __builtin_amdgcn_rcpf(1.f + __expf(-x)); }
__device__ __forceinline__ float sigmoid_f(float x) { return __builtin_amdgcn_rcpf(1.f + __expf(-x)); }
constexpr int E_TP = 32768, E_T = 33792;
struct EpiSwiGLU {
    static constexpr bool PERM = true, AFTER_DRAIN = false;
    bf16_t* O; int ldc;
    __device__ __forceinline__ void operator()(const f32x4 (&acc)[2][2][4][2], const Unit& u, int wr, int wc, int fr, int fq) const {
        const int row0 = u.pm * BM + wr * 64 + fr; const int col0 = u.pn * HALF + wc * 32 + 8 * fq;
#pragma unroll
        for (int ai = 0; ai < 2; ++ai)
#pragma unroll
            for (int m = 0; m < 4; ++m) { const int rr = wr * 64 + fr + ai * HALF + m * 16;
                bf16_t* rowp = O + (size_t)u.pm * 256 * ldc + (size_t)(col0 >> 6) * 16384 + rr * 64 + (col0 & 63);
                const f32x4 g0 = acc[ai][0][m][0], g1 = acc[ai][0][m][1], u0 = acc[ai][1][m][0], u1 = acc[ai][1][m][1];
                float v[8];
#pragma unroll
                for (int j = 0; j < 4; ++j) { v[j] = silu_f(g0[j]) * u0[j]; v[4 + j] = silu_f(g1[j]) * u1[j]; }
                u32x4 w; w.x = cvt_pk_bf16(v[0], v[1]); w.y = cvt_pk_bf16(v[2], v[3]); w.z = cvt_pk_bf16(v[4], v[5]); w.w = cvt_pk_bf16(v[6], v[7]);
                *(u32x4*)rowp = w; }
    }
};
struct EpiZ {
    static constexpr bool PERM = true, AFTER_DRAIN = false;
    bf16_t* Z; float* kp; float* ks; bf16_t* KF;
    __device__ __forceinline__ void operator()(const f32x4 (&acc)[2][2][4][2], const Unit& u, int wr, int wc, int fr, int fq) const {
        const int row0 = u.pm * BM + wr * 64 + fr; const int colt = u.pn * BM + wc * 32 + 8 * fq;
        const bool sig = (u.pn >= 10);
        const bool kout = (u.pn == 2 || u.pn == 3) && (u.pm >= 128 || (u.pm & 63) >= 62);
#pragma unroll
        for (int ai = 0; ai < 2; ++ai)
#pragma unroll
            for (int m = 0; m < 4; ++m) { const int row = row0 + ai * HALF + m * 16;
#pragma unroll
                for (int bj = 0; bj < 2; ++bj) { const int col = colt + bj * HALF; f32x4 v0 = acc[ai][bj][m][0], v1 = acc[ai][bj][m][1];
                    if (sig) {
#pragma unroll
                        for (int j = 0; j < 4; ++j) { v0[j] = sigmoid_f(v0[j]); v1[j] = sigmoid_f(v1[j]); } }
                    u32x4 w; w.x = cvt_pk_bf16(v0[0], v0[1]); w.y = cvt_pk_bf16(v0[2], v0[3]); w.z = cvt_pk_bf16(v1[0], v1[1]); w.w = cvt_pk_bf16(v1[2], v1[3]);
                    if (u.pn == 2 || u.pn == 3) { const int cc = col - 512, hh = cc >> 6, dd = cc & 63;
                        *(u32x4*)(KF + ((((size_t)(row >> 5) * 8 + hh) * 4 + (dd >> 4)) * 64 + ((dd >> 3) & 1) * 32 + (row & 31)) * 8) = w; }
                    else *(u32x4*)(Z + (size_t)row * 3072 + col) = w;
                    if (kout) { float* dst = (u.pm >= 128) ? ks + (size_t)(row - E_TP) * 512 + (col - 512)
                                                           : kp + (size_t)((row >> 14) * 512 + ((row & 16383) - 15872)) * 512 + (col - 512);
                        *(f32x4*)dst = v0; *(f32x4*)(dst + 4) = v1; } } }
    }
};
struct EpiVT {
    static constexpr bool PERM = true, AFTER_DRAIN = false;
    bf16_t* VT; float* vp; float* vs;
    __device__ __forceinline__ void operator()(const f32x4 (&acc)[2][2][4][2], const Unit& u, int wr, int wc, int fr, int fq) const {
        const int row0 = u.pm * BM + wr * 64 + fr; const int colt = u.pn * BM + wc * 32 + 8 * fq;
        const bool vout = (u.pn >= 128 || (u.pn & 63) >= 62);
#pragma unroll
        for (int ai = 0; ai < 2; ++ai)
#pragma unroll
            for (int m = 0; m < 4; ++m) { const int row = row0 + ai * HALF + m * 16;
#pragma unroll
                for (int bj = 0; bj < 2; ++bj) { const int col = colt + bj * HALF; const f32x4 v0 = acc[ai][bj][m][0], v1 = acc[ai][bj][m][1];
                    u32x4 w; w.x = cvt_pk_bf16(v0[0], v0[1]); w.y = cvt_pk_bf16(v0[2], v0[3]); w.z = cvt_pk_bf16(v1[0], v1[1]); w.w = cvt_pk_bf16(v1[2], v1[3]);
                    { const int hh = row >> 6, dd = row & 63, tl = col & 31;
                      bf16_t* dst = VT + ((((((size_t)(col >> 5) * 8 + hh) * 2 + (dd >> 5)) * 2 + (tl >> 4)) * 64 + (dd & 31)) * 8) + ((tl >> 3) & 1) * 4;
                      u32x2 w0; w0.x = w.x; w0.y = w.y; u32x2 w1; w1.x = w.z; w1.y = w.w;
                      *(u32x2*)dst = w0; *(u32x2*)(dst + 32 * 8) = w1; }
                    if (vout) {
#pragma unroll
                        for (int j = 0; j < 8; ++j) { const int tok = col + j; const float val = j < 4 ? v0[j & 3] : v1[j & 3];
                            float* dst = (u.pn >= 128) ? vs + (size_t)(tok - E_TP) * 512 + row
                                                       : vp + (size_t)((tok >> 14) * 512 + ((tok & 16383) - 15872)) * 512 + row;
                            *dst = val; } } } }
    }
};
struct EpiResIn {
    static constexpr bool PERM = false, AFTER_DRAIN = false; static constexpr float scale = 0.5f;
    const float* xp; const float* xs; bf16_t* outb; float* slab;
    __device__ __forceinline__ void operator()(const f32x4 (&acc)[2][2][4][2], const Unit& u, int wr, int wc, int fr, int fq) const {
        const int row0 = u.pm * BM + wr * 64 + fr; const int col0 = u.pn * BM + wc * 32 + 4 * fq;
        if (u.kp >= 0) {
#pragma unroll
            for (int ai = 0; ai < 2; ++ai)
#pragma unroll
                for (int m = 0; m < 4; ++m) { const int row = row0 + ai * HALF + m * 16; float* sp = slab + ((size_t)u.kp * 1024 + (row - E_TP)) * 1024;
#pragma unroll
                    for (int bj = 0; bj < 2; ++bj)
#pragma unroll
                        for (int n = 0; n < 2; ++n) *(f32x4*)(sp + col0 + bj * HALF + n * 16) = acc[ai][bj][m][n] * scale; }
            return; }
#pragma unroll
        for (int ai = 0; ai < 2; ++ai) { f32x4 b[4][2][2];
#pragma unroll
            for (int m = 0; m < 4; ++m) { const int row = row0 + ai * HALF + m * 16;
                const float* bp = row < E_TP ? xp + (size_t)row * 1024 : xs + (size_t)(row - E_TP) * 1024;
#pragma unroll
                for (int bj = 0; bj < 2; ++bj)
#pragma unroll
                    for (int n = 0; n < 2; ++n) b[m][bj][n] = *(const f32x4*)(bp + col0 + bj * HALF + n * 16); }
            asm volatile("" ::: "memory");
#pragma unroll
            for (int m = 0; m < 4; ++m) { bf16_t* op = outb + (size_t)(row0 + ai * HALF + m * 16) * 1024;
#pragma unroll
                for (int bj = 0; bj < 2; ++bj)
#pragma unroll
                    for (int n = 0; n < 2; ++n) { const f32x4 o = b[m][bj][n] + acc[ai][bj][m][n] * scale; u32x2 w; w.x = cvt_pk_bf16(o[0], o[1]); w.y = cvt_pk_bf16(o[2], o[3]);
                        *(u32x2*)(op + col0 + bj * HALF + n * 16) = w; } }
            asm volatile("" ::: "memory"); }
    }
};
template <int SC2> struct EpiResB {
    static constexpr bool PERM = false, AFTER_DRAIN = false; static constexpr float scale = 0.5f * SC2;
    const bf16_t* base; bf16_t* outb; float* slab;
    __device__ __forceinline__ void operator()(const f32x4 (&acc)[2][2][4][2], const Unit& u, int wr, int wc, int fr, int fq) const {
        const int row0 = u.pm * BM + wr * 64 + fr; const int col0 = u.pn * BM + wc * 32 + 4 * fq;
        if (u.kp >= 0) {
#pragma unroll
            for (int ai = 0; ai < 2; ++ai)
#pragma unroll
                for (int m = 0; m < 4; ++m) { const int row = row0 + ai * HALF + m * 16; float* sp = slab + ((size_t)u.kp * 1024 + (row - E_TP)) * 1024;
#pragma unroll
                    for (int bj = 0; bj < 2; ++bj)
#pragma unroll
                        for (int n = 0; n < 2; ++n) *(f32x4*)(sp + col0 + bj * HALF + n * 16) = acc[ai][bj][m][n] * scale; }
            return; }
        u32x2 b[2][4][2][2];
#pragma unroll
        for (int ai = 0; ai < 2; ++ai)
#pragma unroll
            for (int m = 0; m < 4; ++m) { const bf16_t* bp = base + (size_t)(row0 + ai * HALF + m * 16) * 1024;
#pragma unroll
                for (int bj = 0; bj < 2; ++bj)
#pragma unroll
                    for (int n = 0; n < 2; ++n) b[ai][m][bj][n] = *(const u32x2*)(bp + col0 + bj * HALF + n * 16); }
        asm volatile("" ::: "memory");
#pragma unroll
        for (int ai = 0; ai < 2; ++ai)
#pragma unroll
            for (int m = 0; m < 4; ++m) { bf16_t* op = outb + (size_t)(row0 + ai * HALF + m * 16) * 1024;
#pragma unroll
                for (int bj = 0; bj < 2; ++bj)
#pragma unroll
                    for (int n = 0; n < 2; ++n) { const u32x2 bb = b[ai][m][bj][n]; f32x4 o;
                        o[0] = __uint_as_float(bb.x << 16); o[1] = __uint_as_float(bb.x & 0xffff0000u); o[2] = __uint_as_float(bb.y << 16); o[3] = __uint_as_float(bb.y & 0xffff0000u);
                        o = o + acc[ai][bj][m][n] * scale; u32x2 w; w.x = cvt_pk_bf16(o[0], o[1]); w.y = cvt_pk_bf16(o[2], o[3]);
                        *(u32x2*)(op + col0 + bj * HALF + n * 16) = w; } }
    }
};
template <int SC2> struct EpiRes {
    static constexpr bool PERM = false, AFTER_DRAIN = false; static constexpr float scale = 0.5f * SC2;
    const float* xp; const float* xs; float* out; float* slab;
    __device__ __forceinline__ void operator()(const f32x4 (&acc)[2][2][4][2], const Unit& u, int wr, int wc, int fr, int fq) const {
        const int row0 = u.pm * BM + wr * 64 + fr; const int col0 = u.pn * BM + wc * 32 + 4 * fq;
        if (u.kp >= 0) {
#pragma unroll
            for (int ai = 0; ai < 2; ++ai)
#pragma unroll
                for (int m = 0; m < 4; ++m) { const int row = row0 + ai * HALF + m * 16; float* sp = slab + ((size_t)u.kp * 1024 + (row - E_TP)) * 1024;
#pragma unroll
                    for (int bj = 0; bj < 2; ++bj)
#pragma unroll
                        for (int n = 0; n < 2; ++n) *(f32x4*)(sp + col0 + bj * HALF + n * 16) = acc[ai][bj][m][n] * scale; }
            return; }
#pragma unroll
        for (int ai = 0; ai < 2; ++ai) { f32x4 b[4][2][2];
#pragma unroll
            for (int m = 0; m < 4; ++m) { const int row = row0 + ai * HALF + m * 16;
                const float* bp = xp ? (row < E_TP ? xp + (size_t)row * 1024 : xs + (size_t)(row - E_TP) * 1024) : out + (size_t)row * 1024;
#pragma unroll
                for (int bj = 0; bj < 2; ++bj)
#pragma unroll
                    for (int n = 0; n < 2; ++n) b[m][bj][n] = *(const f32x4*)(bp + col0 + bj * HALF + n * 16); }
            asm volatile("" ::: "memory");
#pragma unroll
            for (int m = 0; m < 4; ++m) { float* op = out + (size_t)(row0 + ai * HALF + m * 16) * 1024;
#pragma unroll
                for (int bj = 0; bj < 2; ++bj)
#pragma unroll
                    for (int n = 0; n < 2; ++n) *(f32x4*)(op + col0 + bj * HALF + n * 16) = b[m][bj][n] + acc[ai][bj][m][n] * scale; }
            asm volatile("" ::: "memory"); }
    }
};
template <class Epi, class Sched, bool ALIGN_EPI = false, bool SP2 = false, bool PK = false>
__device__ __forceinline__ void gemm_phase(PG8_LAS unsigned char* lds, const Gemm g, const Sched& S, const Epi& E) {
    const int tid = threadIdx.x, wid = __builtin_amdgcn_readfirstlane(tid >> 6), lane = tid & 63, wr = wid >> 2, wc = wid & 3, fr = lane & 15, fq = lane >> 4;
    const int K = g.K;
    unsigned voffA[2], voffB[2];
#pragma unroll
    for (int i = 0; i < 2; ++i) { int R, C; stage_rc(tid * 16 + i * 8192, R, C); const int Rb = Epi::PERM ? ((R & ~31) + perm32(R & 31)) : R;
        voffA[i] = (unsigned)(R * (PK ? BK : K) + C) * 2u; voffB[i] = (unsigned)(Rb * (PK ? BK : K) + C) * 2u; }
    const size_t kstep = PK ? (size_t)(BM * BK * 2) : (size_t)(BK * 2);
    const size_t hstep = PK ? (size_t)(HALF * BK * 2) : (size_t)HALF * K * 2;
    const size_t tstep = (size_t)BM * K * 2;
    const unsigned ldsw = (unsigned)wid * 1024u;
    const int aoff = lds_byte(wr * 64 + fr, fq * 8), boff = lds_byte(wc * 32 + fr, fq * 8);
#define PG8_SA(b, h) (((b) * 2 + (h)) * HTB)
#define PG8_SB(b, h) ((4 + (b) * 2 + (h)) * HTB)
#define PG8_STAGE(bufoff, gbase, voff) do { _Pragma("unroll") for (int _i = 0; _i < 2; ++_i) \
        __builtin_amdgcn_global_load_lds((const unsigned*)((const char*)(gbase) + (voff)[_i]), (PG8_LAS unsigned*)(lds + (bufoff) + ldsw + _i * 8192), 16, 0, 0); } while (0)
#define PG8_LDA(dst, b, h) do { _Pragma("unroll") for (int m = 0; m < 4; ++m) _Pragma("unroll") for (int k = 0; k < 2; ++k) dst[m][k] = *(const PG8_LAS bf16x8*)(lds + PG8_SA(b, h) + aoff + m * 2048 + k * 1024); } while (0)
#define PG8_LDB(dst, b, h) do { _Pragma("unroll") for (int n = 0; n < 2; ++n) _Pragma("unroll") for (int k = 0; k < 2; ++k) dst[n][k] = *(const PG8_LAS bf16x8*)(lds + PG8_SB(b, h) + boff + n * 2048 + k * 1024); } while (0)
#define PG8_MMA(ai, bj, At, Bt) do { __builtin_amdgcn_s_setprio(1); _Pragma("unroll") for (int m = 0; m < 4; ++m) _Pragma("unroll") for (int n = 0; n < 2; ++n) _Pragma("unroll") for (int k = 0; k < 2; ++k) \
        acc[ai][bj][m][n] = __builtin_amdgcn_mfma_f32_16x16x32_bf16(Bt[n][k], At[m][k], acc[ai][bj][m][n], 0, 0, 0); __builtin_amdgcn_s_setprio(0); } while (0)
#define PG8_WAIT_V(n) asm volatile("s_waitcnt vmcnt(" #n ")" ::: "memory")
#define PG8_WAIT_L(n) asm volatile("s_waitcnt lgkmcnt(" #n ")" ::: "memory")
#define PG8_BAR __builtin_amdgcn_s_barrier()
#define PG8_SCHED __builtin_amdgcn_sched_barrier(0)
    Unit cur, nxt; int ui = 0;
    if (!S.next(0, cur)) return;
    f32x4 acc[2][2][4][2];
#pragma unroll
    for (int a = 0; a < 2; ++a)
#pragma unroll
        for (int b = 0; b < 2; ++b)
#pragma unroll
            for (int m = 0; m < 4; ++m)
#pragma unroll
                for (int n = 0; n < 2; ++n) acc[a][b][m][n] = (f32x4){0.f, 0.f, 0.f, 0.f};
    bf16x8 At[4][2], B0[2][2], B1[2][2];
    const char* cA = (const char*)g.A + (size_t)cur.pm * tstep + (PK ? (size_t)(cur.k0 / BK) * kstep : (size_t)cur.k0 * 2); const char* cB = (const char*)g.Bt + (size_t)cur.pn * tstep + (PK ? (size_t)(cur.k0 / BK) * kstep : (size_t)cur.k0 * 2);
    S.a_ready(cur);
    if constexpr (SP2) {
        PG8_STAGE(PG8_SB(0, 0), cB, voffB); PG8_STAGE(PG8_SB(0, 1), cB + hstep, voffB); PG8_STAGE(PG8_SA(0, 0), cA, voffA); PG8_STAGE(PG8_SA(0, 1), cA + hstep, voffA);
        if (wr == 1) PG8_BAR;
        PG8_WAIT_V(2); PG8_BAR;
        PG8_STAGE(PG8_SB(1, 0), cB + kstep, voffB); PG8_STAGE(PG8_SA(1, 0), cA + kstep, voffA); PG8_STAGE(PG8_SB(1, 1), cB + hstep + kstep, voffB);
        PG8_WAIT_V(6); PG8_BAR;
    } else {
        PG8_STAGE(PG8_SB(0, 0), cB, voffB); PG8_STAGE(PG8_SA(0, 0), cA, voffA); PG8_STAGE(PG8_SB(0, 1), cB + hstep, voffB); PG8_STAGE(PG8_SA(0, 1), cA + hstep, voffA);
        if (wr == 1) PG8_BAR;
        PG8_WAIT_V(4); PG8_BAR;
        PG8_STAGE(PG8_SB(1, 0), cB + kstep, voffB); PG8_STAGE(PG8_SA(1, 0), cA + kstep, voffA); PG8_STAGE(PG8_SB(1, 1), cB + hstep + kstep, voffB);
        PG8_WAIT_V(6); PG8_BAR;
    }
    for (;;) {
        const bool has_next = S.next(ui + 1, nxt);
        const char* nA = has_next ? (const char*)g.A + (size_t)nxt.pm * tstep + (PK ? (size_t)(nxt.k0 / BK) * kstep : (size_t)nxt.k0 * 2) : cA; const char* nB = has_next ? (const char*)g.Bt + (size_t)nxt.pn * tstep + (PK ? (size_t)(nxt.k0 / BK) * kstep : (size_t)nxt.k0 * 2) : cB;
        const int nt = cur.nt;
        for (int t = 0; t < nt; t += 2) {
            const bool last = (t == nt - 2);
            const char* a1 = cA + (size_t)(t + 1) * kstep;
            const char* a2 = last ? nA : cA + (size_t)(t + 2) * kstep; const char* b2 = last ? nB : cB + (size_t)(t + 2) * kstep;
            const char* a3 = a2 + kstep; const char* b3 = b2 + kstep;
            if (last && has_next) S.a_ready(nxt);
            if constexpr (SP2) {
            PG8_LDB(B0, 0, 0); PG8_LDB(B1, 0, 1); PG8_SCHED; PG8_LDA(At, 0, 0); PG8_STAGE(PG8_SA(1, 1), a1 + hstep, voffA);
            PG8_WAIT_V(8); PG8_WAIT_L(0); PG8_BAR; PG8_MMA(0, 0, At, B0); PG8_MMA(0, 1, At, B1); PG8_BAR; PG8_SCHED;
            PG8_LDA(At, 0, 1); PG8_STAGE(PG8_SB(0, 0), b2, voffB); PG8_STAGE(PG8_SB(0, 1), b2 + hstep, voffB); PG8_STAGE(PG8_SA(0, 0), a2, voffA);
            PG8_WAIT_V(8); PG8_WAIT_L(0); PG8_BAR; PG8_MMA(1, 0, At, B0); PG8_MMA(1, 1, At, B1); PG8_BAR; PG8_SCHED;
            PG8_LDB(B0, 1, 0); PG8_LDB(B1, 1, 1); PG8_SCHED; PG8_LDA(At, 1, 0); PG8_STAGE(PG8_SA(0, 1), a2 + hstep, voffA);
            PG8_WAIT_V(8); PG8_WAIT_L(0); PG8_BAR; PG8_MMA(0, 0, At, B0); PG8_MMA(0, 1, At, B1); PG8_BAR; PG8_SCHED;
            PG8_LDA(At, 1, 1); PG8_STAGE(PG8_SB(1, 0), b3, voffB); PG8_STAGE(PG8_SB(1, 1), b3 + hstep, voffB); PG8_STAGE(PG8_SA(1, 0), a3, voffA);
            PG8_WAIT_V(8); PG8_WAIT_L(0); PG8_BAR; PG8_MMA(1, 0, At, B0); PG8_MMA(1, 1, At, B1); PG8_BAR; PG8_SCHED;
            } else {
            PG8_LDB(B0, 0, 0); PG8_SCHED; PG8_LDA(At, 0, 0); PG8_STAGE(PG8_SA(1, 1), a1 + hstep, voffA);
            PG8_WAIT_L(8); PG8_BAR; PG8_WAIT_L(0); PG8_MMA(0, 0, At, B0); PG8_BAR; PG8_SCHED;
            PG8_LDB(B1, 0, 1); PG8_STAGE(PG8_SB(0, 0), b2, voffB);
            PG8_BAR; PG8_WAIT_L(0); PG8_MMA(0, 1, At, B1); PG8_BAR;
            PG8_LDA(At, 0, 1); PG8_STAGE(PG8_SA(0, 0), a2, voffA);
            PG8_BAR; PG8_WAIT_L(0); PG8_MMA(1, 0, At, B0); PG8_BAR; PG8_SCHED;
            PG8_STAGE(PG8_SB(0, 1), b2 + hstep, voffB);
            PG8_WAIT_V(6); PG8_BAR; PG8_MMA(1, 1, At, B1); PG8_BAR;
            PG8_LDB(B0, 1, 0); PG8_SCHED; PG8_LDA(At, 1, 0); PG8_STAGE(PG8_SA(0, 1), a2 + hstep, voffA);
            PG8_WAIT_L(8); PG8_BAR; PG8_WAIT_L(0); PG8_MMA(0, 0, At, B0); PG8_BAR; PG8_SCHED;
            PG8_LDB(B1, 1, 1); PG8_STAGE(PG8_SB(1, 0), b3, voffB);
            PG8_BAR; PG8_WAIT_L(0); PG8_MMA(0, 1, At, B1); PG8_BAR;
            PG8_LDA(At, 1, 1); PG8_STAGE(PG8_SA(1, 0), a3, voffA);
            PG8_BAR; PG8_WAIT_L(0); PG8_MMA(1, 0, At, B0); PG8_BAR; PG8_SCHED;
            PG8_STAGE(PG8_SB(1, 1), b3 + hstep, voffB);
            PG8_WAIT_V(6); PG8_BAR; PG8_MMA(1, 1, At, B1); PG8_BAR;
            }
        }
        if constexpr (ALIGN_EPI) { if (wr == 0) PG8_BAR; }
        if constexpr (!Epi::AFTER_DRAIN) { E(acc, cur, wr, wc, fr, fq); S.done(cur); }
        if (!has_next) break;
#pragma unroll
        for (int a = 0; a < 2; ++a)
#pragma unroll
            for (int b = 0; b < 2; ++b)
#pragma unroll
                for (int m = 0; m < 4; ++m)
#pragma unroll
                    for (int n = 0; n < 2; ++n) acc[a][b][m][n] = (f32x4){0.f, 0.f, 0.f, 0.f};
        cur = nxt; cA = nA; cB = nB; ++ui;
        if constexpr (ALIGN_EPI) { if (wr == 1) PG8_BAR; }
    }
    PG8_WAIT_V(0);
    if constexpr (!ALIGN_EPI) { if (wr == 0) PG8_BAR; }
    PG8_BAR;
    if constexpr (Epi::AFTER_DRAIN) { E.fused(acc, cur, wr, wc, fr, fq, lds, wid, lane); S.done(cur); }
#undef PG8_SA
#undef PG8_SB
#undef PG8_STAGE
#undef PG8_LDA
#undef PG8_LDB
#undef PG8_MMA
#undef PG8_WAIT_V
#undef PG8_WAIT_L
#undef PG8_BAR
#undef PG8_SCHED
}
}
#define LAS __attribute__((address_space(3)))
typedef unsigned short bf16;
typedef short bf16x8 __attribute__((ext_vector_type(8)));
typedef float f32x4 __attribute__((ext_vector_type(4)));
typedef float f32x16 __attribute__((ext_vector_type(16)));
typedef unsigned u32x4 __attribute__((ext_vector_type(4)));
typedef unsigned u32x2 __attribute__((ext_vector_type(2)));
typedef float f32x2_t __attribute__((ext_vector_type(2)));
typedef __bf16 bf16x2_t __attribute__((ext_vector_type(2)));

constexpr int TP = 32768, TS = 1024, T = TP + TS, DM = 1024, FF = 2816, NZ = 3072;
constexpr int NU_P = 2048, NU_S = 128, NU = NU_P + NU_S;
constexpr int NWAVES = 8, NTHR = 512;
constexpr size_t MiB = 1u << 20;
constexpr size_t WS_CTL = 0, CTL_BYTES = 1 * MiB;
constexpr size_t WS_W13A = 2 * MiB, WS_W2A = 13 * MiB, WS_WIN = 19 * MiB, WS_WV = 25 * MiB, WS_WOUT = 26 * MiB, WS_W13B = 28 * MiB, WS_W2B = 39 * MiB;
constexpr size_t WS_H = 46 * MiB;
constexpr size_t WS_BIG = 112 * MiB;
constexpr size_t WS_VT = 310 * MiB;
constexpr size_t WS_G = 343 * MiB;
constexpr size_t WS_QC = 345 * MiB, WS_KC = 378 * MiB;
constexpr size_t WS_DC = 411 * MiB;
constexpr size_t WS_DN = 46661632;
constexpr size_t WS_SC = WS_DN + 1114112;
constexpr size_t WS_KF = 479 * MiB;
constexpr size_t WS_END = 512 * MiB;
constexpr size_t O_Y = 0, O_KP = 34603008, O_VP = 35127296, O_CP = 35651584, O_NP = 35782656, O_MP = 35783680, O_CVP = 35783688,
                 O_KS = 35789832, O_VS = 36314120, O_CS = 36838408, O_NS = 38935560, O_MS = 38951944, O_CVS = 38952072, O_END = 39050376;
constexpr int LDS_BYTES = 147456;

__device__ __forceinline__ unsigned pk2(float lo, float hi) { f32x2_t v = {lo, hi}; bf16x2_t b = __builtin_convertvector(v, bf16x2_t); return __builtin_bit_cast(unsigned, b); }
__device__ __forceinline__ float bflo(unsigned u) { return __uint_as_float(u << 16); }
__device__ __forceinline__ float bfhi(unsigned u) { return __uint_as_float(u & 0xffff0000u); }
__device__ __forceinline__ float bf2f(bf16 b) { return __uint_as_float((unsigned)b << 16); }
__device__ __forceinline__ bf16 f2bf(float f) { return (bf16)(pk2(f, 0.f) & 0xffffu); }
__device__ __forceinline__ float wave_sum(float v) {
#pragma unroll
    for (int o = 1; o < 64; o <<= 1) v += __shfl_xor(v, o);
    return v;
}
__device__ __forceinline__ float wave_max(float v) {
#pragma unroll
    for (int o = 1; o < 64; o <<= 1) v = fmaxf(v, __shfl_xor(v, o));
    return v;
}
__device__ __forceinline__ int crow(int r, int hi) { return (r & 3) + 8 * (r >> 2) + 4 * hi; }
#define MFMA32(a, b, c) __builtin_amdgcn_mfma_f32_32x32x16_bf16((a), (b), (c), 0, 0, 0)
__device__ __forceinline__ bf16x8 pack8f(const float* x) { u32x4 p; p.x = pk2(x[0], x[1]); p.y = pk2(x[2], x[3]); p.z = pk2(x[4], x[5]); p.w = pk2(x[6], x[7]); return __builtin_bit_cast(bf16x8, p); }
__device__ __forceinline__ float silu(float x) { return x * __builtin_amdgcn_rcpf(1.f + __expf(-x)); }
__device__ __forceinline__ float log_sigmoid(float x) { return fminf(x, 0.f) - log1pf(__expf(-fabsf(x))); }

__device__ __forceinline__ void transpose_item(const float* W, int ldn, int K, bf16* WTrow0, int k0, int n0, LAS float* scr, int lane, bool packed = false) {
#pragma unroll 8
    for (int i = 0; i < 32; ++i) { const int kk = 2 * i + (lane >> 5); scr[kk * 33 + (lane & 31)] = W[(size_t)(k0 + kk) * ldn + n0 + (lane & 31)]; }
    asm volatile("s_waitcnt lgkmcnt(0)" ::: "memory");
    const int c = lane & 7;
#pragma unroll
    for (int j = 0; j < 4; ++j) { const int n = (lane >> 3) + 8 * j; const LAS float* s = scr + (8 * c) * 33 + n;
        u32x4 o; o.x = pk2(s[0 * 33], s[1 * 33]); o.y = pk2(s[2 * 33], s[3 * 33]); o.z = pk2(s[4 * 33], s[5 * 33]); o.w = pk2(s[6 * 33], s[7 * 33]);
        if (packed) *(u32x4*)(WTrow0 + (size_t)(n0 >> 8) * 256 * K + (size_t)(k0 >> 6) * 16384 + ((n0 & 255) + n) * 64 + 8 * c) = o;
        else *(u32x4*)(WTrow0 + (size_t)n * K + k0 + 8 * c) = o; }
    asm volatile("s_waitcnt lgkmcnt(0)" ::: "memory");
}
struct Ptrs { const float* in[25]; float* out; unsigned char* ws; int ph_lo, ph_hi, coop, pad; };

__device__ __forceinline__ void p0_weights(const Ptrs& P, LAS float* scr, int gw, int NGW, int lane, int it_lo, int it_hi, int it_skip_lo, int it_skip_hi) {
    constexpr int I_F = 1408, I_IN = 1792, I_OUT = 512;
    constexpr int NIT = 6 * I_F + I_IN + I_OUT;
    unsigned char* ws = P.ws;
    for (int it0 = it_lo + gw; it0 < it_hi; it0 += NGW) {
        const int it = it0 >= it_skip_lo ? it0 + (it_skip_hi - it_skip_lo) : it0; if (it >= NIT) break;
        int r = it;
        if (r < 6 * I_F) {
            const int f = r / (3 * I_F); r -= f * 3 * I_F;
            const int mt = r / I_F; r -= mt * I_F;
            bf16* W13 = (bf16*)(ws + (f ? WS_W13B : WS_W13A)); bf16* W2 = (bf16*)(ws + (f ? WS_W2B : WS_W2A));
            const int base = f ? 21 : 9;
            if (mt < 2) { const int kb = r / 88, nb = r % 88, n0 = nb * 32;
                transpose_item(P.in[base + mt], FF, DM, W13 + (size_t)((n0 >> 7) * 256 + mt * 128 + (n0 & 127)) * DM, kb * 64, n0, scr, lane); }
            else { const int kb = r / 32, nb = r % 32, n0 = nb * 32;
                transpose_item(P.in[base + 2], DM, FF, W2, kb * 64, n0, scr, lane, true); }
            continue;
        }
        r -= 6 * I_F;
        if (r < I_IN) { const int kb = r / 112, nb = r % 112, n0 = nb * 32;
            bf16* dst = n0 < 1024 ? (bf16*)(ws + WS_WIN) + (size_t)n0 * DM : n0 < 1536 ? (bf16*)(ws + WS_WV) + (size_t)(n0 - 1024) * DM : (bf16*)(ws + WS_WIN) + (size_t)(n0 - 512) * DM;
            transpose_item(P.in[13], 3592, DM, dst, kb * 64, n0, scr, lane); continue; }
        r -= I_IN;
        { const int kb = r / 32, nb = r % 32, n0 = nb * 32; transpose_item(P.in[19], DM, DM, (bf16*)(ws + WS_WOUT) + (size_t)n0 * DM, kb * 64, n0, scr, lane); }
    }
}

template <int MODE>
__device__ __forceinline__ void rms_rows(const float* xp, const float* xs, const float* gain, bf16* H, float* outf, const LAS float* gwl, const float* gbias, float* G, int gw, int NGW, int lane, const float* slab, int nsplit, float* xwb) {
    f32x4 g[4];
#pragma unroll
    for (int j = 0; j < 4; ++j) g[j] = ((const f32x4*)gain)[lane + 64 * j];
    f32x4 vn[4];
    if (gw < T) { const float* xr0 = (xs && gw >= TP) ? xs + (size_t)(gw - TP) * DM : xp + (size_t)gw * DM;
#pragma unroll
        for (int j = 0; j < 4; ++j) vn[j] = ((const f32x4*)xr0)[lane + 64 * j]; }
    for (int m = gw; m < T; m += NGW) {
        f32x4 v[4]; float s = 0.f;
#pragma unroll
        for (int j = 0; j < 4; ++j) v[j] = vn[j];
        { const int mn = m + NGW; if (mn < T) { const float* xrn = (xs && mn >= TP) ? xs + (size_t)(mn - TP) * DM : xp + (size_t)mn * DM;
#pragma unroll
            for (int j = 0; j < 4; ++j) vn[j] = ((const f32x4*)xrn)[lane + 64 * j]; } }
        if (nsplit && m >= TP) {
            for (int kp = 0; kp < nsplit; ++kp) { const f32x4* sp = (const f32x4*)(slab + ((size_t)kp * 1024 + (m - TP)) * DM);
#pragma unroll
                for (int j = 0; j < 4; ++j) v[j] += sp[lane + 64 * j]; }
            if (MODE != 2) {
#pragma unroll
                for (int j = 0; j < 4; ++j) ((f32x4*)(xwb + (size_t)m * DM))[lane + 64 * j] = v[j]; }
        }
#pragma unroll
        for (int j = 0; j < 4; ++j) s += (v[j].x * v[j].x + v[j].y * v[j].y) + (v[j].z * v[j].z + v[j].w * v[j].w);
        s = wave_sum(s);
        const float rstd = 1.0f / sqrtf(s * (1.0f / DM) + 1e-6f);
#pragma unroll
        for (int j = 0; j < 4; ++j) v[j] = v[j] * rstd * g[j];
        if (MODE == 2) {
#pragma unroll
            for (int j = 0; j < 4; ++j) ((f32x4*)(outf + (size_t)m * DM))[lane + 64 * j] = v[j];
        } else {
#pragma unroll
            for (int j = 0; j < 4; ++j) { u32x2 w; w.x = pk2(v[j].x, v[j].y); w.y = pk2(v[j].z, v[j].w); ((u32x2*)(H + (size_t)m * DM))[lane + 64 * j] = w; }
        }
        if (MODE == 1) {
            float a8[8];
#pragma unroll
            for (int q = 0; q < 8; ++q) a8[q] = 0.f;
#pragma unroll
            for (int j = 0; j < 4; ++j)
#pragma unroll
                for (int i = 0; i < 4; ++i) { const LAS f32x4* wp = (const LAS f32x4*)(gwl + ((j * 4 + i) * 64 + lane) * 8); const f32x4 w0 = wp[0], w1 = wp[1]; const float xv = v[j][i];
                    a8[0] += xv * w0.x; a8[1] += xv * w0.y; a8[2] += xv * w0.z; a8[3] += xv * w0.w; a8[4] += xv * w1.x; a8[5] += xv * w1.y; a8[6] += xv * w1.z; a8[7] += xv * w1.w; }
#pragma unroll
            for (int q = 0; q < 8; ++q) a8[q] = wave_sum(a8[q]);
            float val = a8[0];
#pragma unroll
            for (int q = 1; q < 8; ++q) val = (lane == q) ? a8[q] : val;
            if (lane < 8) { val += gbias[lane]; if (lane >= 4) val = log_sigmoid(val); G[(size_t)m * 8 + lane] = val; }
        }
    }
}
template <int MODE>
__device__ __forceinline__ void rms_rows_b(bf16* XS, const float* gain, bf16* H, const LAS float* gwl, const float* gbias, float* G, int gw, int NGW, int lane, const float* slab, int nsplit, float* xsamp) {
    f32x4 g[4];
#pragma unroll
    for (int j = 0; j < 4; ++j) g[j] = ((const f32x4*)gain)[lane + 64 * j];
    u32x2 nb[4];
    if (gw < T) {
#pragma unroll
        for (int j = 0; j < 4; ++j) nb[j] = ((const u32x2*)(XS + (size_t)gw * DM))[lane + 64 * j]; }
    for (int m = gw; m < T; m += NGW) {
        f32x4 v[4]; float s = 0.f;
#pragma unroll
        for (int j = 0; j < 4; ++j) { v[j].x = bflo(nb[j].x); v[j].y = bfhi(nb[j].x); v[j].z = bflo(nb[j].y); v[j].w = bfhi(nb[j].y); }
        { const int mn = m + NGW; if (mn < T) {
#pragma unroll
            for (int j = 0; j < 4; ++j) nb[j] = ((const u32x2*)(XS + (size_t)mn * DM))[lane + 64 * j]; } }
        if (m >= TP) {
            for (int kp = 0; kp < nsplit; ++kp) { const f32x4* sp = (const f32x4*)(slab + ((size_t)kp * 1024 + (m - TP)) * DM);
#pragma unroll
                for (int j = 0; j < 4; ++j) v[j] += sp[lane + 64 * j]; }
#pragma unroll
            for (int j = 0; j < 4; ++j) { u32x2 w; w.x = pk2(v[j].x, v[j].y); w.y = pk2(v[j].z, v[j].w); ((u32x2*)(XS + (size_t)m * DM))[lane + 64 * j] = w;
                if (xsamp) ((f32x4*)(xsamp + (size_t)(m - TP) * DM))[lane + 64 * j] = v[j]; }
        }
#pragma unroll
        for (int j = 0; j < 4; ++j) s += (v[j].x * v[j].x + v[j].y * v[j].y) + (v[j].z * v[j].z + v[j].w * v[j].w);
        s = wave_sum(s);
        const float rstd = 1.0f / sqrtf(s * (1.0f / DM) + 1e-6f);
#pragma unroll
        for (int j = 0; j < 4; ++j) v[j] = v[j] * rstd * g[j];
#pragma unroll
        for (int j = 0; j < 4; ++j) { u32x2 w; w.x = pk2(v[j].x, v[j].y); w.y = pk2(v[j].z, v[j].w); ((u32x2*)(H + (size_t)m * DM))[lane + 64 * j] = w; }
        if (MODE == 1) {
            float a8[8];
#pragma unroll
            for (int q = 0; q < 8; ++q) a8[q] = 0.f;
#pragma unroll
            for (int j = 0; j < 4; ++j)
#pragma unroll
                for (int i = 0; i < 4; ++i) { const LAS f32x4* wp = (const LAS f32x4*)(gwl + ((j * 4 + i) * 64 + lane) * 8); const f32x4 w0 = wp[0], w1 = wp[1]; const float xv = v[j][i];
                    a8[0] += xv * w0.x; a8[1] += xv * w0.y; a8[2] += xv * w0.z; a8[3] += xv * w0.w; a8[4] += xv * w1.x; a8[5] += xv * w1.y; a8[6] += xv * w1.z; a8[7] += xv * w1.w; }
#pragma unroll
            for (int q = 0; q < 8; ++q) a8[q] = wave_sum(a8[q]);
            float val = a8[0];
#pragma unroll
            for (int q = 1; q < 8; ++q) val = (lane == q) ? a8[q] : val;
            if (lane < 8) { val += gbias[lane]; if (lane >= 4) val = log_sigmoid(val); G[(size_t)m * 8 + lane] = val; }
        }
    }
}

#define ATT_LOADK(kf, kb_) do { const int kb__ = (kb_); \
        if (kb__ < nkb_cache) { \
            const float* kp = ck + ((size_t)(cb * 512 + kb__ * 32 + r32) * 8 + h) * 64 + hi * 8; \
            _Pragma("unroll") for (int ds = 0; ds < 4; ++ds) { const f32x4 a = *(const f32x4*)(kp + ds * 16), b = *(const f32x4*)(kp + ds * 16 + 4); \
                u32x4 p; p.x = pk2(a.x, a.y); p.y = pk2(a.z, a.w); p.z = pk2(b.x, b.y); p.w = pk2(b.z, b.w); kf[ds] = __builtin_bit_cast(bf16x8, p); } \
        } else { \
            const int kr = krow0 + (kb__ - nkb_cache) * 32; \
            _Pragma("unroll") for (int ds = 0; ds < 4; ++ds) kf[ds] = *(const bf16x8*)(KF + ((((size_t)(kr >> 5) * 8 + h) * 4 + ds) * 64 + lane) * 8); \
        } } while (0)
#define ATT_LOADV(vf, kb_) do { const int kb__ = (kb_); \
        if (kb__ < nkb_cache) { \
            _Pragma("unroll") for (int db = 0; db < 2; ++db) _Pragma("unroll") for (int ks = 0; ks < 2; ++ks) { float t8[8]; \
                _Pragma("unroll") for (int j = 0; j < 8; ++j) { const int key = kb__ * 32 + 16 * ks + 8 * (j >> 2) + 4 * hi + (j & 3); t8[j] = cv[((size_t)(cb * 512 + key) * 8 + h) * 64 + db * 32 + r32]; } \
                vf[db][ks] = pack8f(t8); } \
        } else { \
            const int kr = krow0 + (kb__ - nkb_cache) * 32; \
            _Pragma("unroll") for (int db = 0; db < 2; ++db) _Pragma("unroll") for (int ks = 0; ks < 2; ++ks) vf[db][ks] = *(const bf16x8*)(VT + ((((((size_t)(kr >> 5) * 8 + h) * 2 + db) * 2 + ks) * 64 + lane) * 8)); \
        } } while (0)
__device__ __forceinline__ float xh_max(float v) { auto rr = __builtin_amdgcn_permlane32_swap(__float_as_uint(v), __float_as_uint(v), false, false); return fmaxf(__uint_as_float(rr[0]), __uint_as_float(rr[1])); }
__device__ __forceinline__ float xh_sum(float v) { auto rr = __builtin_amdgcn_permlane32_swap(__float_as_uint(v), __float_as_uint(v), false, false); return __uint_as_float(rr[0]) + __uint_as_float(rr[1]); }
#define ATT_QK(st, kf) do { _Pragma("unroll") for (int qb = 0; qb < NQB; ++qb) { \
            _Pragma("unroll") for (int r = 0; r < 16; ++r) st[qb][r] = 0.f; \
            _Pragma("unroll") for (int ds = 0; ds < 4; ++ds) st[qb] = MFMA32(kf[ds], qf[qb][ds], st[qb]); } } while (0)
#define ATT_SM_PV(st, vf, kb_) do { const int kposb = kpos0 + (kb_) * 32; \
        _Pragma("unroll") for (int qb = 0; qb < NQB; ++qb) { \
            const int qposb = qpos0 + qb * 32; \
            float bm = -1e30f; \
            if (qposb - kposb - 31 >= 128) { const float bias = rb[256]; \
                _Pragma("unroll") for (int r = 0; r < 16; ++r) { st[qb][r] = st[qb][r] * C2 + bias; bm = fmaxf(bm, st[qb][r]); } \
            } else { const int dq = qposb + r32 - kposb; \
                _Pragma("unroll") for (int r = 0; r < 16; ++r) { int d = dq - crow(r, hi); d = d < -128 ? -128 : (d > 128 ? 128 : d); st[qb][r] = st[qb][r] * C2 + rb[d + 128]; bm = fmaxf(bm, st[qb][r]); } \
            } \
            bm = xh_max(bm); \
            const float mnew = fmaxf(mrun[qb], bm), f = __builtin_amdgcn_exp2f(mrun[qb] - mnew); \
            float ps = 0.f; float p[16]; \
            _Pragma("unroll") for (int r = 0; r < 16; ++r) { p[r] = __builtin_amdgcn_exp2f(st[qb][r] - mnew); ps += p[r]; } \
            lrun[qb] = lrun[qb] * f + ps; mrun[qb] = mnew; \
            _Pragma("unroll") for (int db = 0; db < 2; ++db) _Pragma("unroll") for (int r = 0; r < 16; ++r) O[qb][db][r] *= f; \
            const bf16x8 p0 = pack8f(p), p1 = pack8f(p + 8); \
            _Pragma("unroll") for (int db = 0; db < 2; ++db) { O[qb][db] = MFMA32(vf[db][0], p0, O[qb][db]); O[qb][db] = MFMA32(vf[db][1], p1, O[qb][db]); } \
        } } while (0)
template <int NQB>
__device__ __forceinline__ void attn_unit(const bf16* Z, const bf16* KF, const bf16* VT, const float* ck, const float* cv, bf16* MIX, const LAS float* rb,
                                          int h, int qrow0, int krow0, int nkb_cache, int nkb_new, int cb, int qpos0, int kpos0, int lane) {
    const int r32 = lane & 31, hi = lane >> 5; constexpr float C2 = 0.125f * 1.4426950408889634f;
    bf16x8 qf[NQB][4];
#pragma unroll
    for (int qb = 0; qb < NQB; ++qb)
#pragma unroll
        for (int ds = 0; ds < 4; ++ds) qf[qb][ds] = *(const bf16x8*)(Z + (size_t)(qrow0 + qb * 32 + r32) * NZ + h * 64 + ds * 16 + hi * 8);
    float mrun[NQB], lrun[NQB]; f32x16 O[NQB][2];
#pragma unroll
    for (int qb = 0; qb < NQB; ++qb) { mrun[qb] = -1e30f; lrun[qb] = 0.f;
#pragma unroll
        for (int db = 0; db < 2; ++db)
#pragma unroll
            for (int r = 0; r < 16; ++r) O[qb][db][r] = 0.f; }
    const int nkb = nkb_cache + nkb_new;
    bf16x8 kfA[4], kfB[4], vf[2][2]; f32x16 st[NQB];
    ATT_LOADK(kfA, 0);
    for (int kb = 0; kb < nkb; kb += 2) {
        ATT_LOADV(vf, kb);
        if (kb + 1 < nkb) ATT_LOADK(kfB, kb + 1);
        ATT_QK(st, kfA); ATT_SM_PV(st, vf, kb);
        if (kb + 1 < nkb) { ATT_LOADV(vf, kb + 1);
            if (kb + 2 < nkb) ATT_LOADK(kfA, kb + 2);
            ATT_QK(st, kfB); ATT_SM_PV(st, vf, kb + 1); }
    }
#pragma unroll
    for (int qb = 0; qb < NQB; ++qb) {
        const float lt = xh_sum(lrun[qb]); const float inv = 1.0f / lt;
        bf16* op = MIX + (size_t)(qrow0 + qb * 32 + r32) * DM + h * 64 + 4 * hi;
#pragma unroll
        for (int db = 0; db < 2; ++db)
#pragma unroll
            for (int a = 0; a < 4; ++a) { u32x2 w; w.x = pk2(O[qb][db][4 * a] * inv, O[qb][db][4 * a + 1] * inv); w.y = pk2(O[qb][db][4 * a + 2] * inv, O[qb][db][4 * a + 3] * inv);
                *(u32x2*)(op + db * 32 + 8 * a) = w; }
    }
}
#undef ATT_LOADK
#undef ATT_LOADV
#undef ATT_QK
#undef ATT_SM_PV

constexpr int VT_LD = 72;
__device__ __forceinline__ int tix(int row, int col) { return row * VT_LD + ((((col >> 3) ^ (row >> 3)) & 7) << 3) + (col & 7); }
constexpr int ML_WK = 16384, ML_VT = ML_WK + 128 * VT_LD * 2, ML_F = ML_VT + 128 * VT_LD * 2;
__device__ __forceinline__ void unit_gates(const float* G, int row0, int L, int h, int lane, float& b, float& g, float& bL, float& Gmax) {
    const bool valid = lane < L;
    const float ig = valid ? G[(size_t)(row0 + lane) * 8 + h] : 0.f, lf = valid ? G[(size_t)(row0 + lane) * 8 + 4 + h] : 0.f;
    b = lf;
#pragma unroll
    for (int o = 1; o < 64; o <<= 1) { const float x = __shfl_up(b, o); if (lane >= o) b += x; }
    g = valid ? ig - b : -1e30f;
    Gmax = wave_max(g);
    bL = __shfl(b, L - 1);
}
__device__ __forceinline__ void unit_decode(int u, int& row0, int& L, int& h, int& c, int& sb) {
    if (u < NU_P) { const int b = u >> 10; c = (u >> 2) & 255; h = u & 3; row0 = b * 16384 + c * 64; L = 64; sb = -1; }
    else { const int v = u - NU_P; sb = v >> 2; h = v & 3; c = 0; row0 = TP + sb * 32; L = 32; }
}
constexpr int ML_GATE = 57344;
__device__ __forceinline__ void mlstm_m1_phase(const Ptrs& P, LAS unsigned char* lds, int tid, int wave, int lane, int G_) {
    unsigned char* ws = P.ws;
    const bf16* Z = (const bf16*)(ws + WS_BIG); const float* G = (const float*)(ws + WS_G);
    bf16* QC = (bf16*)(ws + WS_QC); bf16* KC = (bf16*)(ws + WS_KC); bf16* DC = (bf16*)(ws + WS_DC); float* DN = (float*)(ws + WS_DN); float* SC = (float*)(ws + WS_SC);
    LAS bf16* wkT = (LAS bf16*)(lds + ML_WK); LAS bf16* vT = (LAS bf16*)(lds + ML_VT); LAS float* gt = (LAS float*)(lds + ML_GATE);
    const int nun = (NU - (int)blockIdx.x + G_ - 1) / G_;
    for (int k = wave; k < nun; k += NWAVES) { const int u = blockIdx.x + k * G_; int row0, L, h, c, sb; unit_decode(u, row0, L, h, c, sb);
        float b, g, bL, Gm; unit_gates(G, row0, L, h, lane, b, g, bL, Gm); LAS float* sWk = gt + (k & 15) * 68; sWk[lane] = (lane < L) ? __expf(g - Gm) : 0.f;
        if (lane == 0) { SC[2 * u] = bL; SC[2 * u + 1] = Gm;
            if (sb >= 0) { const int chn = u - NU_P; const float m = P.in[6][chn], Mx = fmaxf(m, Gm); sWk[64] = __expf(m - Mx); sWk[65] = __expf(Gm - Mx); P.out[O_MS + chn] = bL + Mx; } } }
    const int cg = tid & 31; const bool isk = cg >= 16; const int s0 = tid >> 5; const int vg = tid & 15; const int sv0 = tid >> 4;
    u32x4 zr[4][4], vr[2];
#define M1_LOAD(uu) do { int row0_, L_, h_, c_, sb_; unit_decode((uu), row0_, L_, h_, c_, sb_); const int ch_ = (isk ? 512 : 0) + h_ * 128 + 8 * (cg & 15); const int nit_ = L_ >> 4; \
        _Pragma("unroll") for (int i = 0; i < 4; ++i) if (i < nit_) _Pragma("unroll") for (int j = 0; j < 4; ++j) { const int p = s0 + 16 * i - 3 + j; \
            if (p >= 0 || c_ > 0) zr[i][j] = *(const u32x4*)(Z + (size_t)(row0_ + p) * NZ + 1024 + ch_); \
            else if (sb_ >= 0) { const float* sp = P.in[7] + ((size_t)sb_ * 3 + (3 + p)) * 1024 + ch_; const f32x4 a = *(const f32x4*)sp, b2 = *(const f32x4*)(sp + 4); \
                zr[i][j].x = pk2(a.x, a.y); zr[i][j].y = pk2(a.z, a.w); zr[i][j].z = pk2(b2.x, b2.y); zr[i][j].w = pk2(b2.z, b2.w); } \
            else zr[i][j] = (u32x4){0u, 0u, 0u, 0u}; } \
        _Pragma("unroll") for (int i = 0; i < 2; ++i) if (sv0 + 32 * i < L_) vr[i] = *(const u32x4*)(Z + (size_t)(row0_ + sv0 + 32 * i) * NZ + 2048 + h_ * 128 + 8 * vg); } while (0)
    if (nun > 0) M1_LOAD((int)blockIdx.x);
    LAS float* ctab = (LAS float*)(lds + 65536);
    for (int i = tid; i < 5120; i += NTHR) ctab[i] = i < 4096 ? P.in[14][i] : P.in[15][i - 4096];
    __syncthreads();
    for (int k = 0; k < nun; ++k) { const int u = blockIdx.x + k * G_; int row0, L, h, c, sb; unit_decode(u, row0, L, h, c, sb);
        const int ch = (isk ? 512 : 0) + h * 128 + 8 * (cg & 15); const int nit = L >> 4; const LAS float* sWk = gt + (k & 15) * 68;
        f32x4 w[4][2], bb[2];
        {
#pragma unroll
          for (int j = 0; j < 4; ++j) { w[j][0] = *(const LAS f32x4*)(ctab + j * 1024 + ch); w[j][1] = *(const LAS f32x4*)(ctab + j * 1024 + ch + 4); }
          bb[0] = *(const LAS f32x4*)(ctab + 4096 + ch); bb[1] = *(const LAS f32x4*)(ctab + 4096 + ch + 4); }
#pragma unroll
        for (int i = 0; i < 2; ++i) if (sv0 + 32 * i < L) { const u32x4 r = vr[i]; LAS bf16* d = vT + tix(8 * vg, sv0 + 32 * i);
            d[0] = (bf16)(r.x & 0xffff); d[VT_LD] = (bf16)(r.x >> 16); d[2 * VT_LD] = (bf16)(r.y & 0xffff); d[3 * VT_LD] = (bf16)(r.y >> 16);
            d[4 * VT_LD] = (bf16)(r.z & 0xffff); d[5 * VT_LD] = (bf16)(r.z >> 16); d[6 * VT_LD] = (bf16)(r.w & 0xffff); d[7 * VT_LD] = (bf16)(r.w >> 16); }
#pragma unroll
        for (int i = 0; i < 4; ++i) if (i < nit) { const int s_ = s0 + 16 * i;
            float y[8];
#pragma unroll
            for (int e = 0; e < 4; ++e) { y[e] = bb[0][e]; y[4 + e] = bb[1][e]; }
#pragma unroll
            for (int j = 0; j < 4; ++j) { const u32x4 r = zr[i][j]; float x[8];
                x[0] = bflo(r.x); x[1] = bfhi(r.x); x[2] = bflo(r.y); x[3] = bfhi(r.y); x[4] = bflo(r.z); x[5] = bfhi(r.z); x[6] = bflo(r.w); x[7] = bfhi(r.w);
#pragma unroll
                for (int e = 0; e < 4; ++e) { y[e] += x[e] * w[j][0][e]; y[4 + e] += x[4 + e] * w[j][1][e]; } }
            const float sc = isk ? 0.08838834764831845f : 1.0f;
#pragma unroll
            for (int e = 0; e < 8; ++e) y[e] = silu(y[e]) * sc;
            u32x4 o; o.x = pk2(y[0], y[1]); o.y = pk2(y[2], y[3]); o.z = pk2(y[4], y[5]); o.w = pk2(y[6], y[7]);
            { const int d0 = 8 * (cg & 15), rw = row0 + s_; *(u32x4*)((isk ? KC : QC) + (((size_t)((rw >> 5) * 4 + h) * 8 + (d0 >> 4)) * 64 + ((d0 >> 3) & 1) * 32 + (rw & 31)) * 8) = o; }
            if (isk) { const float wk = sWk[s_];
#pragma unroll
                for (int e = 0; e < 8; ++e) wkT[tix(8 * (cg & 15) + e, s_)] = f2bf(y[e] * wk); }
        }
        __syncthreads();
        if (k + 1 < nun) M1_LOAD(u + G_);
        {
            const int r32 = lane & 31, hi = lane >> 5, eb = wave & 3, dp = wave >> 2; const int nks = L >> 4;
#pragma unroll
            for (int dbi = 0; dbi < 2; ++dbi) { const int db = dp * 2 + dbi; f32x16 acc;
#pragma unroll
                for (int r = 0; r < 16; ++r) acc[r] = 0.f;
#pragma unroll
                for (int ks = 0; ks < 4; ++ks) if (ks < nks) { const bf16x8 A = *(const LAS bf16x8*)(wkT + tix(db * 32 + r32, ks * 16 + hi * 8)), B = *(const LAS bf16x8*)(vT + tix(eb * 32 + r32, ks * 16 + hi * 8));
                    acc = MFMA32(A, B, acc); }
                if (sb < 0) {
#pragma unroll
                    for (int a = 0; a < 4; ++a) { u32x2 wv; wv.x = pk2(acc[4 * a], acc[4 * a + 1]); wv.y = pk2(acc[4 * a + 2], acc[4 * a + 3]);
                        *(u32x2*)(DC + ((((size_t)u * 4 + eb) * 8 + 2 * db + (a >> 1)) * 64 + (a & 1) * 32 + r32) * 8 + 4 * hi) = wv; } }
                else { const int chn = u - NU_P; const float dec = sWk[64], gn = sWk[65];
#pragma unroll
                    for (int r = 0; r < 16; ++r) { const size_t ci = (size_t)chn * 16384 + (db * 32 + crow(r, hi)) * 128 + eb * 32 + r32; P.out[O_CS + ci] = dec * P.in[4][ci] + gn * acc[r]; } } }
            if (tid < 128) { float sm = 0.f;
#pragma unroll
                for (int q = 0; q < 8; ++q) if (q * 8 < L) { const u32x4 r = *(const LAS u32x4*)(wkT + tix(tid, q * 8)); sm += (bflo(r.x) + bfhi(r.x)) + (bflo(r.y) + bfhi(r.y)) + (bflo(r.z) + bfhi(r.z)) + (bflo(r.w) + bfhi(r.w)); }
                if (sb < 0) DN[(size_t)u * 128 + tid] = sm; else { const int chn = u - NU_P; P.out[O_NS + chn * 128 + tid] = sWk[64] * P.in[5][chn * 128 + tid] + sWk[65] * sm; } }
        }
        __syncthreads();
    }
#undef M1_LOAD
}
__device__ __forceinline__ void mlstm_m2(const Ptrs& P, LAS unsigned char* lds, int tid, int wave, int lane, int G_) {
    unsigned char* ws = P.ws; float* out = P.out;
    bf16* DC = (bf16*)(ws + WS_DC); float* DN = (float*)(ws + WS_DN); const float* SC = (const float*)(ws + WS_SC); float* SM = (float*)(ws + WS_SC + 65536);
    LAS float* sDec = (LAS float*)lds;
    LAS float* sGn = (LAS float*)(lds + 8192);
    LAS float* sM = (LAS float*)(lds + 16384);
    {
        const int b = wave >> 2, h = wave & 3; float bL[4], Gm[4];
#pragma unroll
        for (int k = 0; k < 4; ++k) { const int u = b * 1024 + (4 * lane + k) * 4 + h; bL[k] = SC[2 * u]; Gm[k] = SC[2 * u + 1]; }
        float A = bL[0], D = Gm[0] + bL[0];
#pragma unroll
        for (int k = 1; k < 4; ++k) { D = fmaxf(D + bL[k], Gm[k] + bL[k]); A += bL[k]; }
#pragma unroll
        for (int o = 1; o < 64; o <<= 1) { const float Ap = __shfl_up(A, o), Dp = __shfl_up(D, o); if (lane >= o) { D = fmaxf(Dp + A, D); A = Ap + A; } }
        const float Ae = __shfl_up(A, 1), De = __shfl_up(D, 1);
        float m = lane ? fmaxf(Ae, De) : 0.f;
#pragma unroll
        for (int k = 0; k < 4; ++k) { const int c = 4 * lane + k; const float Mx = fmaxf(m, Gm[k]); sM[wave * 257 + c] = m; sDec[wave * 256 + c] = __expf(m - Mx); sGn[wave * 256 + c] = __expf(Gm[k] - Mx); m = bL[k] + Mx; }
        if (lane == 63) sM[wave * 257 + 256] = m;
    }
    __syncthreads();
    if (wave == 0) {
        for (int v = blockIdx.x * 64 + lane; v < 16384; v += G_ * 64) { const int ch = v >> 11, off = (v & 2047) * 8, b = ch >> 2, h = ch & 3;
            bf16* p = DC + (size_t)(b * 1024 + h) * 16384 + off; float carry[8];
#pragma unroll
            for (int j = 0; j < 8; ++j) carry[j] = 0.f;
            for (int c = 0; c < 256; c += 16) { u32x4 x[16];
#pragma unroll
                for (int k = 0; k < 16; ++k) x[k] = *(const u32x4*)(p + (size_t)(c + k) * 65536);
#pragma unroll
                for (int k = 0; k < 16; ++k) { const float dec = sDec[ch * 256 + c + k], gn = sGn[ch * 256 + c + k];
                    u32x4 o; o.x = pk2(carry[0], carry[1]); o.y = pk2(carry[2], carry[3]); o.z = pk2(carry[4], carry[5]); o.w = pk2(carry[6], carry[7]);
                    *(u32x4*)(p + (size_t)(c + k) * 65536) = o;
                    carry[0] = dec * carry[0] + gn * bflo(x[k].x); carry[1] = dec * carry[1] + gn * bfhi(x[k].x); carry[2] = dec * carry[2] + gn * bflo(x[k].y); carry[3] = dec * carry[3] + gn * bfhi(x[k].y);
                    carry[4] = dec * carry[4] + gn * bflo(x[k].z); carry[5] = dec * carry[5] + gn * bfhi(x[k].z); carry[6] = dec * carry[6] + gn * bflo(x[k].w); carry[7] = dec * carry[7] + gn * bfhi(x[k].w); } }
            const int pi = off >> 3, ee = (pi >> 9) * 32 + (pi & 31), dd = ((pi >> 6) & 7) * 16 + ((pi >> 5) & 1) * 8;
#pragma unroll
            for (int j = 0; j < 8; ++j) out[O_CP + (size_t)ch * 16384 + (dd + j) * 128 + ee] = carry[j]; }
    } else if (wave == 1) {
        for (int i = blockIdx.x * 64 + lane; i < 1024; i += G_ * 64) { const int ch = i >> 7, d = i & 127, b = ch >> 2, h = ch & 3; float carry = 0.f;
            float* pn = DN + (size_t)(b * 1024 + h) * 128 + d;
            for (int c = 0; c < 256; c += 16) { float x[16];
#pragma unroll
                for (int k = 0; k < 16; ++k) x[k] = pn[(size_t)(c + k) * 512];
#pragma unroll
                for (int k = 0; k < 16; ++k) { pn[(size_t)(c + k) * 512] = carry; carry = sDec[ch * 256 + c + k] * carry + sGn[ch * 256 + c + k] * x[k]; } }
            out[O_NP + ch * 128 + d] = carry; }
    } else if (blockIdx.x == 0) {
        for (int i = tid - 128; i < NU_P; i += NTHR - 128) { const int b = i >> 10, c = (i >> 2) & 255, h = i & 3; SM[i] = sM[(b * 4 + h) * 257 + c]; }
        if (tid >= 128 && tid < 136) out[O_MP + tid - 128] = sM[(tid - 128) * 257 + 256];
    }
}
__device__ __forceinline__ void mlstm_m3_gates(const Ptrs& P, LAS unsigned char* lds, int wave, int lane, int G_) {
    unsigned char* ws = P.ws; const float* G = (const float*)(ws + WS_G); const float* DN = (const float*)(ws + WS_DN); const float* SM = (const float*)(ws + WS_SC + 65536);
    const int nun = (NU - (int)blockIdx.x + G_ - 1) / G_;
    for (int k = wave; k < nun; k += NWAVES) { const int u = blockIdx.x + k * G_; int row0, L, h, c, sb; unit_decode(u, row0, L, h, c, sb);
        LAS float* gtab = (LAS float*)(lds + ML_GATE) + (k & 15) * 384;
        const float* np_ = (sb < 0) ? DN + (size_t)u * 128 : P.in[5] + (size_t)(u - NU_P) * 128; const float n0 = np_[lane], n1 = np_[64 + lane];
        float b, g, bL, Gm; unit_gates(G, row0, L, h, lane, b, g, bL, Gm); const float mc = (sb < 0) ? SM[u] : P.in[6][u - NU_P];
        float Mx = g;
#pragma unroll
        for (int o = 1; o < 64; o <<= 1) { const float x = __shfl_up(Mx, o); if (lane >= o) Mx = fmaxf(Mx, x); }
        const float Mt = fmaxf(mc, Mx);
        gtab[lane] = g; gtab[64 + lane] = Mt; gtab[128 + lane] = __expf(mc - Mt); gtab[192 + lane] = __expf(-(b + Mt)); gtab[256 + lane] = n0; gtab[320 + lane] = n1; }
}
__device__ __forceinline__ void mlstm_m3_unit(const Ptrs& P, LAS unsigned char* lds, int u, int kslot, int tid, int wave, int lane) {
    unsigned char* ws = P.ws;
    const bf16* Z = (const bf16*)(ws + WS_BIG); const float* G = (const float*)(ws + WS_G);
    const bf16* QC = (const bf16*)(ws + WS_QC); const bf16* KC = (const bf16*)(ws + WS_KC); const bf16* DC = (const bf16*)(ws + WS_DC); const float* DN = (const float*)(ws + WS_DN);
    const float* SM = (const float*)(ws + WS_SC + 65536); bf16* MIX = (bf16*)(ws + WS_H);
    LAS bf16* vT = (LAS bf16*)(lds + ML_VT); LAS float* F = (LAS float*)(lds + ML_F);
    const LAS float* gtab = (const LAS float*)(lds + ML_GATE) + (kslot & 15) * 384;
    const LAS float* sg = gtab, *sMt = gtab + 64, *siw = gtab + 128, *semt = gtab + 192, *sN = gtab + 256; LAS float* sSS = F + 384;
    int row0, L, h, c, sb; unit_decode(u, row0, L, h, c, sb);
    const int r32 = lane & 31, hi = lane >> 5, eb = wave & 3, tb = wave >> 2; const bool active = tb * 32 < L; const int t = tb * 32 + r32;
    const int vg = tid & 15; const int sv0 = tid >> 4; u32x4 vr[2];
#pragma unroll
    for (int i = 0; i < 2; ++i) if (sv0 + 32 * i < L) vr[i] = *(const u32x4*)(Z + (size_t)(row0 + sv0 + 32 * i) * NZ + 2048 + h * 128 + 8 * vg);
    bf16x8 qf[8], Kf[2][8], Cf[8]; u32x2 og[4]; f32x4 gnm[4];
    if (active) {
#pragma unroll
        for (int ds = 0; ds < 8; ++ds) qf[ds] = *(const bf16x8*)(QC + (((size_t)(((row0 >> 5) + tb) * 4 + h) * 8 + ds) * 64 + lane) * 8);
#pragma unroll
        for (int ds = 0; ds < 8; ++ds) {
            if (sb < 0) Cf[ds] = *(const bf16x8*)(DC + ((((size_t)u * 4 + eb) * 8 + ds) * 64 + lane) * 8);
            else { const float* cp = P.in[4] + (size_t)(u - NU_P) * 16384 + (size_t)(ds * 16 + hi * 8) * 128 + eb * 32 + r32; float t8[8];
#pragma unroll
                for (int j = 0; j < 8; ++j) t8[j] = cp[j * 128];
                Cf[ds] = pack8f(t8); } }
#pragma unroll
        for (int sbk = 0; sbk < 2; ++sbk) if (sbk <= tb)
#pragma unroll
            for (int ds = 0; ds < 8; ++ds) Kf[sbk][ds] = *(const bf16x8*)(KC + (((size_t)(((row0 >> 5) + sbk) * 4 + h) * 8 + ds) * 64 + lane) * 8);
#pragma unroll
        for (int a = 0; a < 4; ++a) { og[a] = *(const u32x2*)(Z + (size_t)(row0 + t) * NZ + 2560 + h * 128 + eb * 32 + 8 * a + 4 * hi); gnm[a] = *(const f32x4*)(P.in[18] + h * 128 + eb * 32 + 4 * hi + 8 * a); }
    }
#pragma unroll
    for (int i = 0; i < 2; ++i) if (sv0 + 32 * i < L) { const u32x4 r = vr[i]; LAS bf16* d = vT + tix(8 * vg, sv0 + 32 * i);
        d[0] = (bf16)(r.x & 0xffff); d[VT_LD] = (bf16)(r.x >> 16); d[2 * VT_LD] = (bf16)(r.y & 0xffff); d[3 * VT_LD] = (bf16)(r.y >> 16);
        d[4 * VT_LD] = (bf16)(r.z & 0xffff); d[5 * VT_LD] = (bf16)(r.z >> 16); d[6 * VT_LD] = (bf16)(r.w & 0xffff); d[7 * VT_LD] = (bf16)(r.w >> 16); }
    __syncthreads();
    float val[16];
    if (active) {
        f32x16 acc;
#pragma unroll
        for (int r = 0; r < 16; ++r) acc[r] = 0.f;
#pragma unroll
        for (int ds = 0; ds < 8; ++ds) acc = MFMA32(Cf[ds], qf[ds], acc);
        const float iw = siw[t], Mt = sMt[t];
#pragma unroll
        for (int r = 0; r < 16; ++r) acc[r] *= iw;
        float qn = 0.f;
#pragma unroll
        for (int ds = 0; ds < 8; ++ds)
#pragma unroll
            for (int j = 0; j < 8; ++j) qn += bf2f((bf16)qf[ds][j]) * sN[ds * 16 + hi * 8 + j];
        qn = xh_sum(qn);
        float den = iw * qn;
#pragma unroll
        for (int sbk = 0; sbk < 2; ++sbk) if (sbk <= tb) {
            f32x16 st;
#pragma unroll
            for (int r = 0; r < 16; ++r) st[r] = 0.f;
#pragma unroll
            for (int ds = 0; ds < 8; ++ds) st = MFMA32(Kf[sbk][ds], qf[ds], st);
            float p[16]; float ps = 0.f;
#pragma unroll
            for (int r = 0; r < 16; ++r) { const int s_ = sbk * 32 + crow(r, hi); const float w = __expf(fminf(sg[s_] - Mt, 0.f)); p[r] = (s_ <= t) ? st[r] * w : 0.f; ps += p[r]; }
            ps = xh_sum(ps); den += ps;
            const bf16x8 p0 = pack8f(p), p1 = pack8f(p + 8);
            const int vrow = eb * 32 + r32;
            { const u32x2 lo = *(const LAS u32x2*)(vT + tix(vrow, sbk * 32 + 4 * hi)), hh = *(const LAS u32x2*)(vT + tix(vrow, sbk * 32 + 8 + 4 * hi)); u32x4 a; a.x = lo.x; a.y = lo.y; a.z = hh.x; a.w = hh.y; acc = MFMA32(__builtin_bit_cast(bf16x8, a), p0, acc); }
            { const u32x2 lo = *(const LAS u32x2*)(vT + tix(vrow, sbk * 32 + 16 + 4 * hi)), hh = *(const LAS u32x2*)(vT + tix(vrow, sbk * 32 + 24 + 4 * hi)); u32x4 a; a.x = lo.x; a.y = lo.y; a.z = hh.x; a.w = hh.y; acc = MFMA32(__builtin_bit_cast(bf16x8, a), p1, acc); }
        }
        const float inv = 1.0f / fmaxf(fabsf(den), semt[t]);
        float ss = 0.f;
#pragma unroll
        for (int a = 0; a < 4; ++a) {
            val[4 * a] = acc[4 * a] * inv * bflo(og[a].x); val[4 * a + 1] = acc[4 * a + 1] * inv * bfhi(og[a].x); val[4 * a + 2] = acc[4 * a + 2] * inv * bflo(og[a].y); val[4 * a + 3] = acc[4 * a + 3] * inv * bfhi(og[a].y);
            ss += (val[4 * a] * val[4 * a] + val[4 * a + 1] * val[4 * a + 1]) + (val[4 * a + 2] * val[4 * a + 2] + val[4 * a + 3] * val[4 * a + 3]); }
        ss = xh_sum(ss);
        if (hi == 0) sSS[eb * 64 + t] = ss;
    }
    __syncthreads();
    if (active) {
        const float tot = (sSS[t] + sSS[64 + t]) + (sSS[128 + t] + sSS[192 + t]); const float rstd = 1.0f / sqrtf(tot * (1.0f / 128.0f) + 1e-6f);
        bf16* op = MIX + (size_t)(row0 + t) * DM + 512 + h * 128 + eb * 32 + 4 * hi;
#pragma unroll
        for (int a = 0; a < 4; ++a) { const f32x4 gn = gnm[a]; u32x2 w; w.x = pk2(val[4 * a] * rstd * gn.x, val[4 * a + 1] * rstd * gn.y); w.y = pk2(val[4 * a + 2] * rstd * gn.z, val[4 * a + 3] * rstd * gn.w);
            *(u32x2*)(op + 8 * a) = w; }
    }
}

#define XB_TMO      128
#define XB_XCNT(j)  (256  + 64 * (j))
#define XB_XSUB(j)  (1280 + 64 * (j))
#define XB_XGEN(j)  (2304 + 64 * (j))
#define XB_TOP      3328
#define XB_TOPGEN   3392
#define XCD_BAR_WORDS 3456
#define XB_SPIN_CAP (1u << 18)

__device__ __forceinline__ unsigned xb_ld(unsigned* p)              { return __hip_atomic_load(p, __ATOMIC_RELAXED, __HIP_MEMORY_SCOPE_AGENT); }
__device__ __forceinline__ unsigned xb_add(unsigned* p, unsigned v) { return __hip_atomic_fetch_add(p, v, __ATOMIC_RELAXED, __HIP_MEMORY_SCOPE_AGENT); }
__device__ __forceinline__ unsigned xb_xcc_id() { return (unsigned)__builtin_amdgcn_s_getreg((3 << 11) | 20) & 0xFu; }
#define XB_SPIN(cond, bar) do { unsigned _sp = 0; while (cond) { __builtin_amdgcn_s_sleep(1); \
    if ((++_sp & 255u) == 0u) { if (xb_ld(&(bar)[XB_TMO])) break; if (_sp > XB_SPIN_CAP) { atomicAdd(&(bar)[XB_TMO], 1u); break; } } } } while (0)

struct XcdBarrier {
    unsigned* bar; unsigned x;
    volatile LAS unsigned* st;
};

__device__ __forceinline__ XcdBarrier xcd_barrier_post(unsigned* bar, volatile LAS unsigned* st) {
    XcdBarrier b; b.bar = bar; b.x = xb_xcc_id(); b.st = st;
    if (threadIdx.x == 0) (void)xb_add(&bar[XB_XCNT(b.x)], 1u);
    return b;
}
__device__ __forceinline__ void xcd_barrier_complete(unsigned* bar, unsigned x, unsigned& nloc, unsigned& nx) {
    const unsigned G = gridDim.x * gridDim.y * gridDim.z;
    unsigned sum, cnt, mine, sp = 0u;
    for (;;) {
        sum = 0u; cnt = 0u; mine = 0u;
#pragma unroll
        for (unsigned j = 0; j < 16; ++j) { const unsigned c = xb_ld(&bar[XB_XCNT(j)]); sum += c; cnt += (c > 0u) ? 1u : 0u; mine = (j == x) ? c : mine; }
        if (sum == G) break;
        __builtin_amdgcn_s_sleep(1);
        if ((++sp & 255u) == 0u) { if (xb_ld(&bar[XB_TMO])) break; if (sp > XB_SPIN_CAP) { atomicAdd(&bar[XB_TMO], 1u); break; } }
    }
    nloc = mine > 0u ? mine : 1u; nx = cnt > 0u ? cnt : 1u;
}

__device__ __forceinline__ void xcd_barrier(const XcdBarrier& b) {
    asm volatile("s_waitcnt vmcnt(0)" ::: "memory");
    __syncthreads();
    if (threadIdx.x == 0) {
        unsigned* bar = b.bar;
        __builtin_amdgcn_s_waitcnt(0);
        unsigned nloc = b.st[0], nx = b.st[1];
        if (nloc == 0u) { xcd_barrier_complete(bar, b.x, nloc, nx); b.st[0] = nloc; b.st[1] = nx; }
        const unsigned old = xb_add(&bar[XB_XSUB(b.x)], 1u);
        const unsigned gen = old / nloc;
        if (old + 1u == (gen + 1u) * nloc) {
            __builtin_amdgcn_fence(__ATOMIC_RELEASE, "agent");
            asm volatile("s_waitcnt vmcnt(0)" ::: "memory");
            const unsigned og = xb_add(&bar[XB_TOP], 1u);
            const unsigned tg = og / nx;
            if (og + 1u == (tg + 1u) * nx) xb_add(&bar[XB_TOPGEN], 1u);
            else XB_SPIN(xb_ld(&bar[XB_TOPGEN]) == tg, bar);
            __builtin_amdgcn_fence(__ATOMIC_ACQUIRE, "agent");
            xb_add(&bar[XB_XGEN(b.x)], 1u);
            asm volatile("s_waitcnt vmcnt(0)" ::: "memory");
        } else {
            XB_SPIN(xb_ld(&bar[XB_XGEN(b.x)]) == gen, bar);
            __builtin_amdgcn_fence(__ATOMIC_ACQUIRE, "agent");
            asm volatile("s_waitcnt vmcnt(0)" ::: "memory");
        }
    }
    __syncthreads();
}

__global__ void __launch_bounds__(NTHR, 2) fwd_kernel(Ptrs P) {
    extern __shared__ __attribute__((aligned(16))) unsigned char lds_raw[];
    LAS unsigned char* lds = (LAS unsigned char*)lds_raw;
    const int tid = threadIdx.x, lane = tid & 63, wave = __builtin_amdgcn_readfirstlane(tid >> 6);
    const int G_ = gridDim.x, gw = blockIdx.x * NWAVES + wave, NGW = G_ * NWAVES;
    unsigned char* ws = P.ws; float* out = P.out;
    bf16* XS = (bf16*)(out + O_Y);
    float* XSAMP = (float*)(ws + WS_QC + 44 * MiB);
    bf16* H = (bf16*)(ws + WS_H); bf16* ACT = (bf16*)(ws + WS_BIG); bf16* Z = (bf16*)(ws + WS_BIG); bf16* VT = (bf16*)(ws + WS_VT); float* Gt = (float*)(ws + WS_G);
    const int lo = P.ph_lo, hi_ = P.ph_hi;
    volatile LAS unsigned* bst = (volatile LAS unsigned*)(lds + LDS_BYTES - 64);
    if (tid < 16) bst[tid] = 0u;
    __syncthreads();
    XcdBarrier bar; bar.bar = (unsigned*)(ws + WS_CTL) + 4096; bar.x = 0; bar.st = nullptr;
    if (P.coop) bar = xcd_barrier_post((unsigned*)(ws + WS_CTL) + 4096, bst);
#define IN(k) (lo <= (k) && (k) < hi_)
#define SEAM(k) do { if (IN(k) && IN((k) + 1)) { if (P.coop == 2) cg::this_grid().sync(); else xcd_barrier(bar); } } while (0)

    if (IN(0)) { p0_weights(P, (LAS float*)(lds + wave * 16384), gw, NGW, lane, 0, 2816, 1 << 30, 1 << 30);
        for (int i = blockIdx.x * NTHR + tid; i < TS * DM / 4; i += G_ * NTHR) { const f32x4 xv = ((const f32x4*)P.in[1])[i]; u32x2 w; w.x = pk2(xv.x, xv.y); w.y = pk2(xv.z, xv.w); ((u32x2*)(XS + (size_t)TP * DM))[i] = w; } rms_rows<0>(P.in[0], P.in[1], P.in[8], H, nullptr, nullptr, nullptr, nullptr, gw, NGW, lane, nullptr, 0, nullptr); }
    SEAM(0);
    if (IN(1)) { pg8::Gemm g{H, (const bf16*)(ws + WS_W13A), T, 2 * FF, DM}; pg8::StaticOrder S; S.init(T, 2 * FF, G_, (int)blockIdx.x, DM); pg8::EpiSwiGLU E{ACT, FF};
        pg8::gemm_phase<pg8::EpiSwiGLU, pg8::StaticOrder, true, true>(lds, g, S, E);
        {
            const int nwg1 = (T / 256) * (2 * FF / 256), rounds1 = (nwg1 + G_ - 1) / G_, first_idle = nwg1 - (rounds1 - 1) * G_;
            int nid = G_ - first_idle, myid = (int)blockIdx.x - first_idle; if (nid == 0) { nid = G_; myid = (int)blockIdx.x; }
            if (myid >= 0) p0_weights(P, (LAS float*)(lds + wave * 16384), myid * NWAVES + wave, nid * NWAVES, lane, 2816, 6528, 4224, 8448); } }
    SEAM(1);
    if (IN(2)) { pg8::Gemm g{ACT, (const bf16*)(ws + WS_W2A), T, DM, FF}; pg8::TailOrder S; S.init(TP, TS, DM, G_, (int)blockIdx.x, FF, 11); pg8::EpiResIn E{P.in[0], P.in[1], XS, (float*)(ws + WS_QC)};
        pg8::gemm_phase<pg8::EpiResIn, pg8::TailOrder, true, true, true>(lds, g, S, E); }
    SEAM(2);
    if (IN(3)) {
        LAS float* gwl = (LAS float*)lds; const float* win = P.in[13];
        for (int i = tid; i < 8192; i += NTHR) { const int k = i >> 3, q = i & 7; const int l = (k & 255) >> 2, ii = k & 3, j = k >> 8; gwl[((j * 4 + ii) * 64 + l) * 8 + q] = win[(size_t)k * 3592 + 3584 + q]; }
        __syncthreads();
        rms_rows_b<1>(XS, P.in[12], H, gwl, P.in[16], Gt, gw, NGW, lane, (const float*)(ws + WS_QC), 11, nullptr);
        __syncthreads();
    }
    SEAM(3);
    if (IN(4)) {
        { pg8::Gemm g{H, (const bf16*)(ws + WS_WIN), T, NZ, DM}; pg8::StaticOrder S; S.init(T, NZ, G_, (int)blockIdx.x, DM); pg8::EpiZ E{Z, out + O_KP, out + O_KS, (bf16*)(ws + WS_KF)};
          pg8::gemm_phase<pg8::EpiZ, pg8::StaticOrder, true, true>(lds, g, S, E); }
        { pg8::Gemm g{(const bf16*)(ws + WS_WV), H, 512, T, DM}; pg8::StaticOrder S; S.init(512, T, G_, (int)((blockIdx.x + G_ - 48) % G_), DM); pg8::EpiVT E{VT, out + O_VP, out + O_VS};
          pg8::gemm_phase<pg8::EpiVT, pg8::StaticOrder, true, true>(lds, g, S, E); }
    }
    SEAM(4);
    if (IN(5)) {
        LAS float* rb = (LAS float*)lds; const float* rbg = P.in[17];
        for (int i = tid; i < 8 * 257; i += NTHR) rb[i] = rbg[i] * 1.4426950408889634f;
        __syncthreads();
        if (G_ == 256) {
            const int vcu = ((int)blockIdx.x & 7) * 32 + ((int)blockIdx.x >> 3); const int h = wave;
            const int b = vcu >> 7;
            for (int cc = 0; cc < 2; ++cc) { const int c = (vcu & 127) * 2 + cc; const int c0 = c > 8 ? c - 8 : 0;
                attn_unit<2>(Z, (const bf16*)(ws + WS_KF), VT, nullptr, nullptr, H, rb + h * 257, h, b * 16384 + c * 64, b * 16384 + c0 * 64, 0, (c - c0 + 1) * 2, 0, c * 64, c0 * 64, lane); }
        } else
        for (int u = gw + 256; u < 256 + 4096; u += NGW) {
            { const int v = u - 256, h = v & 7, c = (v >> 3) & 255, b = v >> 11; const int c0 = c > 8 ? c - 8 : 0;
                attn_unit<2>(Z, (const bf16*)(ws + WS_KF), VT, nullptr, nullptr, H, rb + h * 257, h, b * 16384 + c * 64, b * 16384 + c0 * 64, 0, (c - c0 + 1) * 2, 0, c * 64, c0 * 64, lane); }
        }
        __syncthreads();
    }
    if (IN(6)) {
        mlstm_m1_phase(P, lds, tid, wave, lane, G_);
        for (int i = blockIdx.x * NTHR + tid; i < 34 * 3 * 1024; i += G_ * NTHR) { const int ch = i & 1023, j = (i >> 10) % 3, b = i / 3072;
            if (b < 2) out[O_CVP + (size_t)(b * 3 + j) * 1024 + ch] = bf2f(Z[(size_t)(b * 16384 + 16381 + j) * NZ + 1024 + ch]);
            else out[O_CVS + (size_t)((b - 2) * 3 + j) * 1024 + ch] = bf2f(Z[(size_t)(TP + (b - 2) * 32 + 29 + j) * NZ + 1024 + ch]); }
    }
    SEAM(6);
    if (IN(7)) {
        LAS float* rb = (LAS float*)(lds + 32768); const float* rbg = P.in[17];
        for (int i = tid; i < 8 * 257; i += NTHR) rb[i] = rbg[i] * 1.4426950408889634f;
        mlstm_m2(P, lds, tid, wave, lane, G_);
        if (wave >= 3) p0_weights(P, (LAS float*)(lds + 49152 + (wave - 3) * 8448), (int)blockIdx.x * 5 + (wave - 3), G_ * 5, lane, 4224, 8448, 1 << 30, 1 << 30);
        if (wave >= 2) for (int u = blockIdx.x + G_ * (wave - 2); u < 256; u += G_ * 6) { const int b = u >> 3, h = u & 7;
            attn_unit<1>(Z, (const bf16*)(ws + WS_KF), VT, P.in[2], P.in[3], H, rb + h * 257, h, TP + b * 32, TP + b * 32, 16, 1, b, 4096, 3584, lane); }
    }
    SEAM(7);
    if (IN(8)) { mlstm_m3_gates(P, lds, wave, lane, G_); __syncthreads(); int kslot = 0; for (int u = blockIdx.x; u < NU; u += G_, ++kslot) mlstm_m3_unit(P, lds, u, kslot, tid, wave, lane); }
    SEAM(8);
    if (IN(9)) { pg8::Gemm g{H, (const bf16*)(ws + WS_WOUT), T, DM, DM}; pg8::TailOrder S; S.init(TP, TS, DM, G_, (int)blockIdx.x, DM, 4); pg8::EpiResB<2> E{XS, XS, (float*)(ws + WS_QC)};
        pg8::gemm_phase<pg8::EpiResB<2>, pg8::TailOrder, true, true>(lds, g, S, E); }
    SEAM(9);
    if (IN(10)) rms_rows_b<0>(XS, P.in[20], H, nullptr, nullptr, nullptr, gw, NGW, lane, (const float*)(ws + WS_QC), 4, XSAMP);
    SEAM(10);
    if (IN(11)) { pg8::Gemm g{H, (const bf16*)(ws + WS_W13B), T, 2 * FF, DM}; pg8::StaticOrder S; S.init(T, 2 * FF, G_, (int)blockIdx.x, DM); pg8::EpiSwiGLU E{ACT, FF};
        pg8::gemm_phase<pg8::EpiSwiGLU, pg8::StaticOrder, true, true>(lds, g, S, E); }
    SEAM(11);
    if (IN(12)) { pg8::Gemm g{ACT, (const bf16*)(ws + WS_W2B), T, DM, FF}; pg8::TailOrder S; S.init(TP, TS, DM, G_, (int)blockIdx.x, FF, 11); pg8::EpiResB<1> E{XS, H, (float*)(ws + WS_QC)};
        pg8::gemm_phase<pg8::EpiResB<1>, pg8::TailOrder, true, true, true>(lds, g, S, E); }
    SEAM(12);
    if (IN(13)) {
        const bf16* X3 = H; const float* slab = (const float*)(ws + WS_QC); float* Y = out + O_Y;
        f32x4 g[4];
#pragma unroll
        for (int j = 0; j < 4; ++j) g[j] = ((const f32x4*)P.in[24])[lane + 64 * j];
        u32x2 nb[4]; f32x4 nf[4];
#define FN_LOAD(mm) do { const int mm_ = (mm); if (mm_ < TP) { _Pragma("unroll") for (int j = 0; j < 4; ++j) nb[j] = __builtin_nontemporal_load(&((const u32x2*)(X3 + (size_t)mm_ * DM))[lane + 64 * j]); } \
            else if (mm_ < T) { _Pragma("unroll") for (int j = 0; j < 4; ++j) nf[j] = ((const f32x4*)(XSAMP + (size_t)(mm_ - TP) * DM))[lane + 64 * j]; } } while (0)
        FN_LOAD(gw);
        for (int m = gw; m < T; m += NGW) { f32x4 v[4];
            if (m < TP) {
#pragma unroll
                for (int j = 0; j < 4; ++j) { v[j].x = bflo(nb[j].x); v[j].y = bfhi(nb[j].x); v[j].z = bflo(nb[j].y); v[j].w = bfhi(nb[j].y); } }
            else {
#pragma unroll
                for (int j = 0; j < 4; ++j) v[j] = nf[j]; }
            FN_LOAD(m + NGW);
            if (m >= TP) for (int kp = 0; kp < 11; ++kp) { const f32x4* sp = (const f32x4*)(slab + ((size_t)kp * 1024 + (m - TP)) * DM);
#pragma unroll
                for (int j = 0; j < 4; ++j) v[j] += sp[lane + 64 * j]; }
            float sq = 0.f;
#pragma unroll
            for (int j = 0; j < 4; ++j) sq += (v[j].x * v[j].x + v[j].y * v[j].y) + (v[j].z * v[j].z + v[j].w * v[j].w);
            sq = wave_sum(sq); const float rstd = 1.0f / sqrtf(sq * (1.0f / DM) + 1e-6f);
#pragma unroll
            for (int j = 0; j < 4; ++j) __builtin_nontemporal_store(v[j] * rstd * g[j], &((f32x4*)(Y + (size_t)m * DM))[lane + 64 * j]); }
#undef FN_LOAD
    }
#undef IN
#undef SEAM
}

#ifndef PROBE_PH
#define PROBE_PH -1
#define PROBE_REP 3
#endif
#ifndef N_LAUNCH_MODE
#define N_LAUNCH_MODE 0
#endif
extern "C" void kernel_launch(void* const* d_in, const int* in_sizes, int n_in, void* d_out, int out_size, void* d_ws, size_t ws_size, hipStream_t stream) {
    static int grid = 0;
    if (grid == 0) {
        if (n_in != 25 || out_size != (int)O_END || ws_size < WS_END) { fprintf(stderr, "kernel_launch: unexpected shapes n_in %d out %d ws %zu\n", n_in, out_size, ws_size); grid = -1; return; }
        int dev = 0, cus = 0, per_cu = 0;
        hipGetDevice(&dev); hipDeviceGetAttribute(&cus, hipDeviceAttributeMultiprocessorCount, dev);
        if (hipFuncSetAttribute((const void*)fwd_kernel, hipFuncAttributeMaxDynamicSharedMemorySize, LDS_BYTES) != hipSuccess) { fprintf(stderr, "kernel_launch: hipFuncSetAttribute failed\n"); grid = -1; return; }
        if (hipOccupancyMaxActiveBlocksPerMultiprocessor(&per_cu, (const void*)fwd_kernel, NTHR, LDS_BYTES) != hipSuccess || per_cu < 1) { fprintf(stderr, "kernel_launch: occupancy query says %d\n", per_cu); per_cu = 1; }
        (void)hipGetLastError();
        grid = cus * 1;
    }
    if (grid < 0) return;
    Ptrs p{};
    for (int i = 0; i < 25; ++i) p.in[i] = (const float*)d_in[i];
    p.out = (float*)d_out; p.ws = (unsigned char*)d_ws;
#if N_LAUNCH_MODE == 1
    for (int ph = 0; ph < 14; ++ph) { const int nrep = (ph == PROBE_PH) ? PROBE_REP : 1;
        for (int r = 0; r < nrep; ++r) { p.ph_lo = ph; p.ph_hi = ph + 1; p.coop = 0; hipLaunchKernelGGL(fwd_kernel, dim3(grid), dim3(NTHR), LDS_BYTES, stream, p); } }
#else
    if (hipMemsetAsync((char*)d_ws + WS_CTL, 0, CTL_BYTES, stream) != hipSuccess) { fprintf(stderr, "kernel_launch: memset failed\n"); return; }
    p.ph_lo = 0; p.ph_hi = 14; p.coop = 1;
    void* args[] = {&p};
    hipError_t e = hipLaunchCooperativeKernel((const void*)fwd_kernel, dim3(grid), dim3(NTHR), args, LDS_BYTES, stream);
    if (e != hipSuccess) fprintf(stderr, "kernel_launch: cooperative launch failed: %s (grid %d)\n", hipGetErrorString(e), grid);
#endif
}
```
